# Optimizing an MI355X kernel written in HIP

```python
import jax, jax.numpy as jnp
from jax import lax
import numpy as np

D_MODEL = 1024
BATCH = 4
SEQ = 8192
DEPTH = 1

GRID_W = 64
CTX_LEN = 256
A_WIDTH = 1024
A_HEAD_DIM = 128
A_HEADS = A_WIDTH // A_HEAD_DIM
A_CHUNK = 64
B_WIDTH = 1024
B_BLOCKS = 8
B_BLOCK_DIM = B_WIDTH // B_BLOCKS
B_CONV = 4
RG_C = 8.0
N_BRANCH = 2
IN_COLS = 5 * A_WIDTH + 2 * B_WIDTH + N_BRANCH * D_MODEL
DEEPNORM_ALPHA = (2 * DEPTH) ** 0.25
DEEPNORM_BETA = (8 * DEPTH) ** -0.25
LN_EPS = 1e-5
RMS_EPS = 1e-6

kernel_name = "hgrn2_rglru_gated_hybrid_dit"


def _in_split_points():
    sizes = [A_WIDTH] * 5 + [B_WIDTH] * 2 + [D_MODEL] * N_BRANCH
    return [int(v) for v in np.cumsum(sizes)[:-1]]


def layer_norm(t, g, b):
    tf = t.astype(jnp.float32)
    mu = jnp.mean(tf, axis=-1, keepdims=True)
    var = jnp.mean(jnp.square(tf - mu), axis=-1, keepdims=True)
    return ((tf - mu) * lax.rsqrt(var + LN_EPS) * g.astype(jnp.float32) + b.astype(jnp.float32)).astype(t.dtype)


def rms_norm(t, g):
    tf = t.astype(jnp.float32)
    return tf * lax.rsqrt(jnp.mean(jnp.square(tf), axis=-1, keepdims=True) + RMS_EPS) * g.astype(jnp.float32)


def to_heads(t):
    b, l, _ = t.shape
    return t.reshape(b, l, A_HEADS, A_HEAD_DIM).transpose(0, 2, 1, 3)


def from_heads(t):
    b, h, l, d = t.shape
    return t.transpose(0, 2, 1, 3).reshape(b, l, h * d)


def grid_to_colmajor(t, rows):
    b, _, ch = t.shape
    return t.reshape(b, rows, GRID_W, ch).transpose(0, 2, 1, 3)


def colmajor_to_grid(t):
    b, w, r, ch = t.shape
    return t.transpose(0, 2, 1, 3).reshape(b, r * w, ch)


def gla_chunkwise(q, k, v, logf, s0):
    b, h, t, dk = q.shape
    dv = v.shape[-1]
    n = t // A_CHUNK
    q = q.reshape(b, h, n, A_CHUNK, dk)
    k = k.reshape(b, h, n, A_CHUNK, dk)
    v = v.reshape(b, h, n, A_CHUNK, dv)
    g = jnp.cumsum(logf.reshape(b, h, n, A_CHUNK, dk), axis=-2)
    g_last = g[..., -1:, :]
    q_dec = q * jnp.exp(g)
    k_inv = k * jnp.exp(-g)
    k_end = k * jnp.exp(g_last - g)
    mask = jnp.tril(jnp.ones((A_CHUNK, A_CHUNK), dtype=bool))
    scores = jnp.where(mask, jnp.einsum('bhnck,bhnsk->bhncs', q_dec, k_inv), 0.0)
    o_intra = jnp.einsum('bhncs,bhnsv->bhncv', scores, v)
    u = jnp.einsum('bhnsk,bhnsv->bhnkv', k_end, v)
    decay = jnp.exp(g_last[..., 0, :])

    def step(s, inp):
        d_n, u_n = inp
        return d_n[..., None] * s + u_n, s

    s_fin, s_start = lax.scan(step, s0, (jnp.moveaxis(decay, 2, 0), jnp.moveaxis(u, 2, 0)))
    s_start = jnp.moveaxis(s_start, 0, 2)
    o_inter = jnp.einsum('bhnck,bhnkv->bhncv', q_dec, s_start)
    return (o_intra + o_inter).reshape(b, h, t, dv), s_fin


def gla_prefixed(ctx_in, lat_in, reverse):
    if reverse:
        ctx_in = tuple(jnp.flip(a, axis=2) for a in ctx_in)
        lat_in = tuple(jnp.flip(a, axis=2) for a in lat_in)
    b, h, _, dk = ctx_in[0].shape
    dv = ctx_in[2].shape[-1]
    s0 = jnp.zeros((b, h, dk, dv), jnp.float32)
    o_c, s_c = gla_chunkwise(*ctx_in, s0)
    o_x, _ = gla_chunkwise(*lat_in, s_c)
    if reverse:
        o_c, o_x = jnp.flip(o_c, axis=2), jnp.flip(o_x, axis=2)
    return o_c, o_x


def hgrn2_features(z, lb):
    f32 = jnp.float32
    q = to_heads(jax.nn.silu(z[0].astype(f32)) * (A_HEAD_DIM ** -0.5))
    v = to_heads(z[3].astype(f32))
    f_fwd = lb[0] + (1.0 - lb[0]) * jax.nn.sigmoid(z[1].astype(f32))
    f_bwd = lb[1] + (1.0 - lb[1]) * jax.nn.sigmoid(z[2].astype(f32))
    fwd = (q, to_heads(1.0 - f_fwd), v, to_heads(jnp.log(f_fwd)))
    bwd = (q, to_heads(1.0 - f_bwd), v, to_heads(jnp.log(f_bwd)))
    return fwd, bwd


def centred_dwconv(t, w, bias):
    lo = (B_CONV - 1) // 2
    hi = B_CONV - 1 - lo
    n = t.shape[-2]
    tp = jnp.pad(t, [(0, 0)] * (t.ndim - 2) + [(lo, hi), (0, 0)])
    out = bias + tp[..., 0:n, :] * w[0]
    for kk in range(1, B_CONV):
        out = out + tp[..., kk:kk + n, :] * w[kk]
    return out


def rglru_gates(xc, w_r, b_r, w_i, b_i, lam):
    b, l, ch = xc.shape
    xb = xc.reshape(b, l, B_BLOCKS, B_BLOCK_DIM)
    r = jax.nn.sigmoid(jnp.einsum('blgi,gij->blgj', xb, w_r).reshape(b, l, ch) + b_r)
    i = jax.nn.sigmoid(jnp.einsum('blgi,gij->blgj', xb, w_i).reshape(b, l, ch) + b_i)
    log_a = -RG_C * r * jax.nn.softplus(-lam)
    a = jnp.exp(log_a)
    mult = jnp.sqrt(-jnp.expm1(2.0 * log_a))
    return a, mult * (i * xc)


def linear_scan(a, bterm, h0):
    bterm = bterm.at[:, 0].add(a[:, 0] * h0)

    def comb(left, right):
        al, bl = left
        ar, br = right
        return al * ar, ar * bl + br

    _, h = lax.associative_scan(comb, (a, bterm), axis=1)
    return h


def rglru_prefixed(xc_c, xc_x, params, reverse):
    if reverse:
        xc_c, xc_x = jnp.flip(xc_c, axis=1), jnp.flip(xc_x, axis=1)
    a_c, b_c = rglru_gates(xc_c, *params)
    h_c = linear_scan(a_c, b_c, jnp.zeros((xc_c.shape[0], B_WIDTH), jnp.float32))
    a_x, b_x = rglru_gates(xc_x, *params)
    h_x = linear_scan(a_x, b_x, h_c[:, -1])
    if reverse:
        h_c, h_x = jnp.flip(h_c, axis=1), jnp.flip(h_x, axis=1)
    return h_c, h_x


def hybrid_layer(x, ctx, c, c_ctx, w_mod, b_mod, w_in, b_in, lb, norm_a_g, conv_w, conv_b,
                 w_r, b_r, w_i, b_i, lam, p_a, p_b, w_out, ln_g, ln_b, last):
    f32 = jnp.float32
    bsz, t, _ = x.shape
    rows = t // GRID_W
    mod_x = jax.nn.silu(c) @ w_mod + b_mod
    mod_c = jax.nn.silu(c_ctx) @ w_mod + b_mod
    sh_x, sc_x, gt_x = jnp.split(mod_x[:, None, :], 3, axis=-1)
    sh_c, sc_c, gt_c = jnp.split(mod_c, 3, axis=-1)
    u_x = x * (1.0 + sc_x) + sh_x
    u_c = ctx * (1.0 + sc_c) + sh_c
    splits = _in_split_points()
    z_x = jnp.split(u_x @ w_in + b_in, splits, axis=-1)
    z_c = jnp.split(u_c @ w_in + b_in, splits, axis=-1)

    fx, bx = hgrn2_features(z_x, lb)
    fc, bc = hgrn2_features(z_c, lb)
    oc_f, ox_f = gla_prefixed(fc, fx, False)
    oc_b, ox_b = gla_prefixed(bc, bx, True)

    xc_x = centred_dwconv(grid_to_colmajor(z_x[5], rows), conv_w, conv_b).astype(f32).reshape(bsz, t, B_WIDTH)
    xc_c = centred_dwconv(z_c[5], conv_w, conv_b).astype(f32)
    hc_f, hx_f = rglru_prefixed(xc_c, xc_x, (w_r[0], b_r[0], w_i[0], b_i[0], lam[0]), False)
    hc_b, hx_b = rglru_prefixed(xc_c, xc_x, (w_r[1], b_r[1], w_i[1], b_i[1], lam[1]), True)
    hx = colmajor_to_grid((hx_f + hx_b).reshape(bsz, GRID_W, rows, B_WIDTH))

    def merge(z, o_a, h_b):
        o_a = from_heads(rms_norm(o_a, norm_a_g)) * jax.nn.silu(z[4].astype(f32))
        o_b = h_b * jax.nn.silu(z[6].astype(f32))
        y = jax.nn.sigmoid(z[7]) * (o_a @ p_a) + jax.nn.sigmoid(z[8]) * (o_b @ p_b)
        return y @ w_out

    x_new = layer_norm(DEEPNORM_ALPHA * x + gt_x * merge(z_x, ox_f + ox_b, hx), ln_g, ln_b)
    if last:
        return x_new, ctx
    ctx_new = layer_norm(DEEPNORM_ALPHA * ctx + gt_c * merge(z_c, oc_f + oc_b, hc_f + hc_b), ln_g, ln_b)
    return x_new, ctx_new


def setup_inputs(seed: int = 0) -> dict:
    key = jax.random.key(seed)
    ks = jax.random.split(key, 24)
    f32 = jnp.float32
    n = lambda k, s, sc: jax.random.normal(k, s, f32) * sc
    u_a = jax.random.uniform(ks[17], (DEPTH, 2, B_WIDTH), f32, 0.9, 0.999)
    s_a = u_a ** (1.0 / RG_C)
    return {
        "x": n(ks[0], (BATCH, SEQ, D_MODEL), 1.0),
        "c": n(ks[1], (BATCH, D_MODEL), 1.0),
        "ctx": n(ks[2], (BATCH, CTX_LEN, D_MODEL), 1.0),
        "c_ctx": n(ks[3], (D_MODEL,), 1.0),
        "w_mod": n(ks[4], (DEPTH, D_MODEL, 3 * D_MODEL), 0.5 * D_MODEL ** -0.5),
        "b_mod": n(ks[5], (DEPTH, 3 * D_MODEL), 0.01),
        "w_in": n(ks[6], (DEPTH, D_MODEL, IN_COLS), D_MODEL ** -0.5),
        "b_in": n(ks[7], (DEPTH, IN_COLS), 0.01),
        "lb_logits": n(ks[8], (DEPTH + 1, 2, A_WIDTH), 0.1),
        "norm_a_g": 1.0 + n(ks[9], (DEPTH, A_HEAD_DIM), 0.01),
        "conv_w": n(ks[10], (DEPTH, B_CONV, B_WIDTH), B_CONV ** -0.5),
        "conv_b": n(ks[11], (DEPTH, B_WIDTH), 0.01),
        "w_r": n(ks[12], (DEPTH, 2, B_BLOCKS, B_BLOCK_DIM, B_BLOCK_DIM), B_BLOCK_DIM ** -0.5),
        "b_r": n(ks[13], (DEPTH, 2, B_WIDTH), 0.01),
        "w_i": n(ks[14], (DEPTH, 2, B_BLOCKS, B_BLOCK_DIM, B_BLOCK_DIM), B_BLOCK_DIM ** -0.5),
        "b_i": n(ks[15], (DEPTH, 2, B_WIDTH), 0.01),
        "lam": jnp.log(s_a) - jnp.log1p(-s_a),
        "p_a": n(ks[18], (DEPTH, A_WIDTH, D_MODEL), DEEPNORM_BETA * A_WIDTH ** -0.5),
        "p_b": n(ks[19], (DEPTH, B_WIDTH, D_MODEL), DEEPNORM_BETA * B_WIDTH ** -0.5),
        "w_out": n(ks[20], (DEPTH, D_MODEL, D_MODEL), DEEPNORM_BETA * D_MODEL ** -0.5),
        "ln_g": 1.0 + n(ks[21], (DEPTH, D_MODEL), 0.01),
        "ln_b": n(ks[22], (DEPTH, D_MODEL), 0.01),
    }


def reference(x, c, ctx, c_ctx, w_mod, b_mod, w_in, b_in, lb_logits, norm_a_g, conv_w, conv_b,
              w_r, b_r, w_i, b_i, lam, p_a, p_b, w_out, ln_g, ln_b):
    lb_all = jnp.cumsum(jax.nn.softmax(lb_logits.astype(jnp.float32), axis=0), axis=0)
    for layer in range(DEPTH):
        x, ctx = hybrid_layer(
            x, ctx, c, c_ctx, w_mod[layer], b_mod[layer], w_in[layer], b_in[layer], lb_all[layer],
            norm_a_g[layer], conv_w[layer], conv_b[layer], w_r[layer], b_r[layer], w_i[layer], b_i[layer],
            lam[layer], p_a[layer], p_b[layer], w_out[layer], ln_g[layer], ln_b[layer],
            last=(layer == DEPTH - 1))
    return x
```

```cpp
#include <hip/hip_runtime.h>
#include <hip/hip_cooperative_groups.h>
#include <cstdio>
#include <cstdint>
namespace pg8 {
#define PG8_LAS __attribute__((address_space(3)))
typedef unsigned short bf16_t;
typedef short bf16x8 __attribute__((ext_vector_type(8)));
typedef float f32x4 __attribute__((ext_vector_type(4)));
typedef unsigned u32x4 __attribute__((ext_vector_type(4)));
constexpr int BM = 256, BK = 64, HALF = 128, HTB = HALF * BK * 2  , STAGE_BYTES = 8 * HTB, NXCD = 8, WGM = 8;

__host__ __device__ __forceinline__ int lds_byte(int r, int c) { const int st = (r >> 4) * 2 + (c >> 5), rr = r & 15, cc = c & 31, ob = rr * 64 + cc * 2; return st * 1024 + (ob ^ (((ob >> 9) & 1) << 5)); }
__host__ __device__ __forceinline__ void stage_rc(int b, int& R, int& C) { const int st = b / 1024, sb = b % 1024, swz = sb ^ (((sb >> 9) & 1) << 5); R = (st >> 1) * 16 + swz / 64; C = (st & 1) * 32 + (swz % 64) / 2; }
__host__ __device__ __forceinline__ int perm32(int rho) { const int n = rho >> 4, i = rho & 15; return 8 * (i >> 2) + 4 * n + (i & 3); }

struct Unit { int pm, pn; };
struct Gemm { const bf16_t* A; const bf16_t* Bt; int M, N, K; };

struct StaticOrder {
    int nM, nN, nwg, G, c;
    __host__ __device__ void init(int M, int N, int G_, int c_) { nM = M / BM; nN = N / BM; nwg = nM * nN; G = G_; c = c_; }
    __host__ __device__ bool next(int i, Unit& u) const {
        const long L = (long)i * G + c; if (L >= nwg) return false;
        int wgid = (int)L; { const int q = nwg / NXCD, r = nwg % NXCD, xcd = wgid % NXCD, off = wgid / NXCD; wgid = (xcd < r ? xcd * (q + 1) : r * (q + 1) + (xcd - r) * q) + off; }
        const int nig = WGM * nN, gid = wgid / nig, fm = gid * WGM, gsz = (nM - fm) < WGM ? (nM - fm) : WGM;
        u.pm = fm + ((wgid % nig) % gsz); u.pn = (wgid % nig) / gsz; return true;
    }
    __device__ __forceinline__ void a_ready(const Unit&) const {}
    __device__ __forceinline__ void done(const Unit&) const {}
};

__device__ __forceinline__ unsigned cvt_pk_bf16(float lo, float hi) { unsigned r; asm volatile("v_cvt_pk_bf16_f32 %0, %1, %2" : "=v"(r) : "v"(lo), "v"(hi)); return r; }
template <class Epi, class Sched, bool ALIGN_EPI = false, bool SP2 = false>
__device__ __forceinline__ void gemm_phase(PG8_LAS unsigned char* lds, const Gemm g, const Sched& S, const Epi& E) {
    const int tid = threadIdx.x, wid = __builtin_amdgcn_readfirstlane(tid >> 6), lane = tid & 63, wr = wid >> 2, wc = wid & 3, fr = lane & 15, fq = lane >> 4;
    const int K = g.K, nt = K / BK;
    unsigned voffA[2], voffB[2];
#pragma unroll
    for (int i = 0; i < 2; ++i) { int R, C; stage_rc(tid * 16 + i * 8192, R, C); const int Rb = Epi::PERM ? ((R & ~31) + perm32(R & 31)) : R;
        voffA[i] = (unsigned)(R * K + C) * 2u; voffB[i] = (unsigned)(Rb * K + C) * 2u; }
    const size_t kstep = (size_t)(BK * 2);
    const size_t hstep = (size_t)HALF * K * 2;
    const size_t tstep = 2 * hstep;
    const unsigned ldsw = (unsigned)wid * 1024u;
    const int aoff = lds_byte(wr * 64 + fr, fq * 8), boff = lds_byte(wc * 32 + fr, fq * 8);
#define PG8_SA(b, h) (((b) * 2 + (h)) * HTB)
#define PG8_SB(b, h) ((4 + (b) * 2 + (h)) * HTB)
#define PG8_STAGE(bufoff, gbase, voff) do { _Pragma("unroll") for (int _i = 0; _i < 2; ++_i) \
        __builtin_amdgcn_global_load_lds((const unsigned*)((const char*)(gbase) + (voff)[_i]), (PG8_LAS unsigned*)(lds + (bufoff) + ldsw + _i * 8192), 16, 0, 0); } while (0)
#define PG8_LDA(dst, b, h) do { _Pragma("unroll") for (int m = 0; m < 4; ++m) _Pragma("unroll") for (int k = 0; k < 2; ++k) dst[m][k] = *(const PG8_LAS bf16x8*)(lds + PG8_SA(b, h) + aoff + m * 2048 + k * 1024); } while (0)
#define PG8_LDB(dst, b, h) do { _Pragma("unroll") for (int n = 0; n < 2; ++n) _Pragma("unroll") for (int k = 0; k < 2; ++k) dst[n][k] = *(const PG8_LAS bf16x8*)(lds + PG8_SB(b, h) + boff + n * 2048 + k * 1024); } while (0)
#define PG8_MMA(ai, bj, At, Bt) do { __builtin_amdgcn_s_setprio(1); _Pragma("unroll") for (int m = 0; m < 4; ++m) _Pragma("unroll") for (int n = 0; n < 2; ++n) _Pragma("unroll") for (int k = 0; k < 2; ++k) \
        acc[ai][bj][m][n] = __builtin_amdgcn_mfma_f32_16x16x32_bf16(Bt[n][k], At[m][k], acc[ai][bj][m][n], 0, 0, 0); __builtin_amdgcn_s_setprio(0); } while (0)
#define PG8_WAIT_V(n) asm volatile("s_waitcnt vmcnt(" #n ")" ::: "memory")
#define PG8_WAIT_L(n) asm volatile("s_waitcnt lgkmcnt(" #n ")" ::: "memory")
#define PG8_BAR __builtin_amdgcn_s_barrier()
#define PG8_SCHED __builtin_amdgcn_sched_barrier(0)
    Unit cur, nxt; int ui = 0;
    if (!S.next(0, cur)) return;
    f32x4 acc[2][2][4][2];
#pragma unroll
    for (int a = 0; a < 2; ++a)
#pragma unroll
        for (int b = 0; b < 2; ++b)
#pragma unroll
            for (int m = 0; m < 4; ++m)
#pragma unroll
                for (int n = 0; n < 2; ++n) acc[a][b][m][n] = (f32x4){0.f, 0.f, 0.f, 0.f};
    bf16x8 At[4][2], B0[2][2], B1[2][2];
    const char* cA = (const char*)g.A + (size_t)cur.pm * tstep; const char* cB = (const char*)g.Bt + (size_t)cur.pn * tstep;
    S.a_ready(cur);
    if constexpr (SP2) {
        PG8_STAGE(PG8_SB(0, 0), cB, voffB); PG8_STAGE(PG8_SB(0, 1), cB + hstep, voffB); PG8_STAGE(PG8_SA(0, 0), cA, voffA); PG8_STAGE(PG8_SA(0, 1), cA + hstep, voffA);
        if (wr == 1) PG8_BAR;
        PG8_WAIT_V(2); PG8_BAR;
        PG8_STAGE(PG8_SB(1, 0), cB + kstep, voffB); PG8_STAGE(PG8_SA(1, 0), cA + kstep, voffA); PG8_STAGE(PG8_SB(1, 1), cB + hstep + kstep, voffB);
        PG8_WAIT_V(6); PG8_BAR;
    } else {
        PG8_STAGE(PG8_SB(0, 0), cB, voffB); PG8_STAGE(PG8_SA(0, 0), cA, voffA); PG8_STAGE(PG8_SB(0, 1), cB + hstep, voffB); PG8_STAGE(PG8_SA(0, 1), cA + hstep, voffA);
        if (wr == 1) PG8_BAR;
        PG8_WAIT_V(4); PG8_BAR;
        PG8_STAGE(PG8_SB(1, 0), cB + kstep, voffB); PG8_STAGE(PG8_SA(1, 0), cA + kstep, voffA); PG8_STAGE(PG8_SB(1, 1), cB + hstep + kstep, voffB);
        PG8_WAIT_V(6); PG8_BAR;
    }
    for (;;) {
        const bool has_next = S.next(ui + 1, nxt);
        const char* nA = has_next ? (const char*)g.A + (size_t)nxt.pm * tstep : cA; const char* nB = has_next ? (const char*)g.Bt + (size_t)nxt.pn * tstep : cB;
        for (int t = 0; t < nt; t += 2) {
            const bool last = (t == nt - 2);
            const char* a1 = cA + (size_t)(t + 1) * kstep;
            const char* a2 = last ? nA : cA + (size_t)(t + 2) * kstep; const char* b2 = last ? nB : cB + (size_t)(t + 2) * kstep;
            const char* a3 = a2 + kstep; const char* b3 = b2 + kstep;
            if (last && has_next) S.a_ready(nxt);
            if constexpr (SP2) {
            PG8_LDB(B0, 0, 0); PG8_LDB(B1, 0, 1); PG8_SCHED; PG8_LDA(At, 0, 0); PG8_STAGE(PG8_SA(1, 1), a1 + hstep, voffA);
            PG8_WAIT_V(8); PG8_WAIT_L(0); PG8_BAR; PG8_MMA(0, 0, At, B0); PG8_MMA(0, 1, At, B1); PG8_BAR; PG8_SCHED;
            PG8_LDA(At, 0, 1); PG8_STAGE(PG8_SB(0, 0), b2, voffB); PG8_STAGE(PG8_SB(0, 1), b2 + hstep, voffB); PG8_STAGE(PG8_SA(0, 0), a2, voffA);
            PG8_WAIT_V(8); PG8_WAIT_L(0); PG8_BAR; PG8_MMA(1, 0, At, B0); PG8_MMA(1, 1, At, B1); PG8_BAR; PG8_SCHED;
            PG8_LDB(B0, 1, 0); PG8_LDB(B1, 1, 1); PG8_SCHED; PG8_LDA(At, 1, 0); PG8_STAGE(PG8_SA(0, 1), a2 + hstep, voffA);
            PG8_WAIT_V(8); PG8_WAIT_L(0); PG8_BAR; PG8_MMA(0, 0, At, B0); PG8_MMA(0, 1, At, B1); PG8_BAR; PG8_SCHED;
            PG8_LDA(At, 1, 1); PG8_STAGE(PG8_SB(1, 0), b3, voffB); PG8_STAGE(PG8_SB(1, 1), b3 + hstep, voffB); PG8_STAGE(PG8_SA(1, 0), a3, voffA);
            PG8_WAIT_V(8); PG8_WAIT_L(0); PG8_BAR; PG8_MMA(1, 0, At, B0); PG8_MMA(1, 1, At, B1); PG8_BAR; PG8_SCHED;
            } else {
            PG8_LDB(B0, 0, 0); PG8_SCHED; PG8_LDA(At, 0, 0); PG8_STAGE(PG8_SA(1, 1), a1 + hstep, voffA);
            PG8_WAIT_L(8); PG8_BAR; PG8_WAIT_L(0); PG8_MMA(0, 0, At, B0); PG8_BAR; PG8_SCHED;
            PG8_LDB(B1, 0, 1); PG8_STAGE(PG8_SB(0, 0), b2, voffB);
            PG8_BAR; PG8_WAIT_L(0); PG8_MMA(0, 1, At, B1); PG8_BAR;
            PG8_LDA(At, 0, 1); PG8_STAGE(PG8_SA(0, 0), a2, voffA);
            PG8_BAR; PG8_WAIT_L(0); PG8_MMA(1, 0, At, B0); PG8_BAR; PG8_SCHED;
            PG8_STAGE(PG8_SB(0, 1), b2 + hstep, voffB);
            PG8_WAIT_V(6); PG8_BAR; PG8_MMA(1, 1, At, B1); PG8_BAR;
            PG8_LDB(B0, 1, 0); PG8_SCHED; PG8_LDA(At, 1, 0); PG8_STAGE(PG8_SA(0, 1), a2 + hstep, voffA);
            PG8_WAIT_L(8); PG8_BAR; PG8_WAIT_L(0); PG8_MMA(0, 0, At, B0); PG8_BAR; PG8_SCHED;
            PG8_LDB(B1, 1, 1); PG8_STAGE(PG8_SB(1, 0), b3, voffB);
            PG8_BAR; PG8_WAIT_L(0); PG8_MMA(0, 1, At, B1); PG8_BAR;
            PG8_LDA(At, 1, 1); PG8_STAGE(PG8_SA(1, 0), a3, voffA);
            PG8_BAR; PG8_WAIT_L(0); PG8_MMA(1, 0, At, B0); PG8_BAR; PG8_SCHED;
            PG8_STAGE(PG8_SB(1, 1), b3 + hstep, voffB);
            PG8_WAIT_V(6); PG8_BAR; PG8_MMA(1, 1, At, B1); PG8_BAR;
            }
        }
        if constexpr (ALIGN_EPI) { if (wr == 0) PG8_BAR; }
        if constexpr (!Epi::AFTER_DRAIN) { E(acc, cur, wr, wc, fr, fq); S.done(cur); }
        if (!has_next) break;
#pragma unroll
        for (int a = 0; a < 2; ++a)
#pragma unroll
            for (int b = 0; b < 2; ++b)
#pragma unroll
                for (int m = 0; m < 4; ++m)
#pragma unroll
                    for (int n = 0; n < 2; ++n) acc[a][b][m][n] = (f32x4){0.f, 0.f, 0.f, 0.f};
        cur = nxt; cA = nA; cB = nB; ++ui;
        if constexpr (ALIGN_EPI) { if (wr == 1) PG8_BAR; }
    }
    PG8_WAIT_V(0);
    if constexpr (!ALIGN_EPI) { if (wr == 0) PG8_BAR; }
    PG8_BAR;
    if constexpr (Epi::AFTER_DRAIN) { E.fused(acc, cur, wr, wc, fr, fq, lds, wid, lane); S.done(cur); }
#undef PG8_SA
#undef PG8_SB
#undef PG8_STAGE
#undef PG8_LDA
#undef PG8_LDB
#undef PG8_MMA
#undef PG8_WAIT_V
#undef PG8_WAIT_L
#undef PG8_BAR
#undef PG8_SCHED
}
}

#define GAS __attribute__((address_space(1)))
#define LAS __attribute__((address_space(3)))
typedef unsigned short bf16_t;
typedef short bf16x8 __attribute__((ext_vector_type(8)));
typedef short s16x4 __attribute__((ext_vector_type(4)));
typedef float f32x4 __attribute__((ext_vector_type(4)));
typedef float f32x16 __attribute__((ext_vector_type(16)));
typedef unsigned u32x4 __attribute__((ext_vector_type(4)));
typedef unsigned u32x2 __attribute__((ext_vector_type(2)));

constexpr int DM = 1024, NB = 4, TL = 8192, TC = 256;
constexpr int LROWS = NB * TL, CROWS = NB * TC, ROWS = LROWS + CROWS;
constexpr int NWAVES = 8, NTHR = 512;
constexpr size_t MiB = 1u << 20;
constexpr size_t SLOT = (size_t)ROWS * DM * 2;
constexpr size_t WS_CTL = 0, CTL_ZERO_BYTES = 1 * MiB;
constexpr size_t WS_WIN = 1 * MiB;
constexpr size_t WS_WPA = 19 * MiB, WS_WPB = 21 * MiB, WS_WOUT = 23 * MiB;
constexpr size_t WS_WG = 25 * MiB;
constexpr size_t WS_MODP = 26 * MiB;
constexpr size_t WS_GT = 27 * MiB;
constexpr size_t WS_DDF = 28 * MiB, WS_DDB = 31 * MiB;
constexpr size_t WS_SLOTS = 34 * MiB;
constexpr size_t WS_END = WS_SLOTS + 7 * SLOT;
static_assert(WS_END <= 512 * MiB, "workspace map");
enum { SL_U = 0, SL_QDF = 1, SL_KIF = 2, SL_QDB = 3, SL_KIB = 4, SL_V = 5, SL_X5 = 6 };
constexpr int CW_BAR = 4096;
constexpr int LDS_BYTES = 147456;
constexpr int MISC_OFF = 139264 + 1024;
static_assert(MISC_OFF + 128 <= LDS_BYTES, "lds map");

__device__ __forceinline__ float bf2f(unsigned short v) { return __uint_as_float((unsigned)v << 16); }
__device__ __forceinline__ float bflo(unsigned u) { return __uint_as_float(u << 16); }
__device__ __forceinline__ float bfhi(unsigned u) { return __uint_as_float(u & 0xffff0000u); }
typedef float f32x2_t __attribute__((ext_vector_type(2))); typedef __bf16 bf16x2_t __attribute__((ext_vector_type(2)));
__device__ __forceinline__ unsigned pk2(float lo, float hi) { const f32x2_t v = {lo, hi}; const bf16x2_t b = __builtin_convertvector(v, bf16x2_t); return __builtin_bit_cast(unsigned, b); }
__device__ __forceinline__ float fexp(float x) { return __builtin_amdgcn_exp2f(x * 1.4426950408889634f); }
__device__ __forceinline__ float flog(float x) { return __builtin_amdgcn_logf(x) * 0.6931471805599453f; }
__device__ __forceinline__ float fsig(float x) { return __builtin_amdgcn_rcpf(1.f + fexp(-x)); }
__device__ __forceinline__ float fsilu(float x) { return x * __builtin_amdgcn_rcpf(1.f + fexp(-x)); }

__device__ __forceinline__ int perm8(int ch) {
    const int tile = ch >> 8, cc = ch & 255, bj = cc >> 7, wc = (cc >> 5) & 3, fq = (cc >> 3) & 3, nn = (cc >> 2) & 1, e = cc & 3;
    return 256 * tile + 128 * bj + 32 * wc + 16 * nn + 4 * fq + e;
}
__device__ __forceinline__ int map_win(int n) {
    const int grp = n >> 10, ch = n & 1023;
    if (grp <= 3) {
        const int h = ch >> 7, half = (ch >> 6) & 1, cc = ch & 63, wc = cc >> 4, fq = (cc >> 2) & 3, e = cc & 3, bj = grp >> 1, nn = grp & 1;
        return 256 * (2 * h + half) + 128 * bj + 32 * wc + 16 * nn + 4 * fq + e;
    }
    if (grp == 5) return 4096 + perm8(ch);
    if (grp == 4) return 5120 + perm8(ch);
    return 6144 + 1024 * (grp - 6) + perm8(ch);
}
template <int MAP>
__device__ __forceinline__ int map_row(int n) { return MAP == 1 ? map_win(n) : (MAP == 2 ? perm8(n) : n); }
template <int MAP>
__device__ __forceinline__ void transpose_item(const float* W, int K, int N, bf16_t* WT, LAS float* scr, int item, int lane) {
    const int nblk = N / 32, kb = item / nblk, nb = item % nblk, k0 = 64 * kb, n0 = 32 * nb;
#pragma unroll 8
    for (int i = 0; i < 32; ++i) { const int kk = 2 * i + (lane >> 5); scr[kk * 33 + (lane & 31)] = W[(size_t)(k0 + kk) * N + n0 + (lane & 31)]; }
    asm volatile("s_waitcnt lgkmcnt(0)" ::: "memory");
    const int c = lane & 7;
#pragma unroll
    for (int j = 0; j < 4; ++j) { const int n = (lane >> 3) + 8 * j; const LAS float* s = scr + (8 * c) * 33 + n;
        u32x4 o; o.x = pk2(s[0 * 33], s[1 * 33]); o.y = pk2(s[2 * 33], s[3 * 33]); o.z = pk2(s[4 * 33], s[5 * 33]); o.w = pk2(s[6 * 33], s[7 * 33]);
        *(u32x4*)(WT + (size_t)map_row<MAP>(n0 + n) * K + k0 + 8 * c) = o; }
    asm volatile("s_waitcnt lgkmcnt(0)" ::: "memory");
}
__device__ __forceinline__ void modp_item(const float* c, const float* c_ctx, const float* w_mod, float* modp, int item, int lane) {
    const int kc = item / 12, cb = item % 12, col = cb * 256 + lane * 4;
    f32x4 acc[5];
#pragma unroll
    for (int r = 0; r < 5; ++r) acc[r] = (f32x4){0.f, 0.f, 0.f, 0.f};
#pragma unroll 8
    for (int kk = 0; kk < 64; ++kk) {
        const int k = kc * 64 + kk;
        const f32x4 wv = *(const f32x4*)(w_mod + (size_t)k * 3072 + col);
#pragma unroll
        for (int r = 0; r < 5; ++r) { const float sv = r < 4 ? c[r * DM + k] : c_ctx[k]; acc[r] += wv * (sv / (1.f + __expf(-sv))); }
    }
#pragma unroll
    for (int r = 0; r < 5; ++r) *(f32x4*)(modp + (size_t)(kc * 5 + r) * 3072 + col) = acc[r];
}

__device__ __forceinline__ void urow(const float* xrow, bf16_t* orow, const LAS float* tab, int lane) {
    const GAS f32x4* xr = (const GAS f32x4*)xrow + lane;
    GAS u32x2* o8 = (GAS u32x2*)orow + lane;
#pragma unroll
    for (int j = 0; j < 4; ++j) {
        const f32x4 v = xr[64 * j];
        const f32x4 sh = *(const LAS f32x4*)(tab + 4 * lane + 256 * j), sc = *(const LAS f32x4*)(tab + 1024 + 4 * lane + 256 * j);
        u32x2 w; w.x = pk2(v.x * sc.x + sh.x, v.y * sc.y + sh.y); w.y = pk2(v.z * sc.z + sh.z, v.w * sc.w + sh.w);
        o8[64 * j] = w;
    }
}

namespace epi {
using pg8::Unit; using pg8::BM; using pg8::HALF;
__device__ __forceinline__ int lane_now() { int l; asm volatile("v_mbcnt_lo_u32_b32 %0, -1, 0\n\tv_mbcnt_hi_u32_b32 %0, -1, %0" : "=v"(l)); return l; }
template <int CTRL> __device__ __forceinline__ float dpp0(float x) { return __int_as_float(__builtin_amdgcn_update_dpp(0, __float_as_int(x), CTRL, 0xF, 0xF, true)); }
__device__ __forceinline__ float rowscan16(float x) {
    x += dpp0<0x111>(x); x += dpp0<0x112>(x); x += dpp0<0x114>(x); x += dpp0<0x118>(x); return x;
}
__device__ __forceinline__ float rowsum16(float x) {
    x += dpp0<0x128>(x); x += dpp0<0x124>(x); x += dpp0<0x122>(x); x += dpp0<0x121>(x); return x;
}
struct EpiMix {
    static constexpr bool PERM = false, AFTER_DRAIN = false;
    bf16_t *QDf, *KIf, *QDb, *KIb, *V, *X5; float *Ddf, *Ddb; const float* b_in; const float* lbl;
    __device__ __forceinline__ void operator()(const f32x4 (&acc)[2][2][4][2], const Unit& u, int wr, int wc, int fr_, int fq_) const {
        const int ln_ = lane_now(), fr = ln_ & 15, fq = ln_ >> 4;
        const int row0 = u.pm * BM + wr * 64 + fr;
        if (u.pn >= 16) {
            const int chb = (u.pn - 16) * 256 + wc * 32 + 8 * fq;
            f32x4 bv[2][2];
#pragma unroll
            for (int bj = 0; bj < 2; ++bj)
#pragma unroll
                for (int n = 0; n < 2; ++n) bv[bj][n] = *(const f32x4*)(b_in + 5120 + chb + bj * HALF + 4 * n);
#pragma unroll
            for (int ai = 0; ai < 2; ++ai)
#pragma unroll
                for (int m = 0; m < 4; ++m) { bf16_t* rowp = X5 + (size_t)(row0 + ai * HALF + m * 16) * DM + chb;
#pragma unroll
                    for (int bj = 0; bj < 2; ++bj) { const f32x4 v0 = acc[ai][bj][m][0] + bv[bj][0], v1 = acc[ai][bj][m][1] + bv[bj][1];
                        u32x4 w; w.x = pk2(v0[0], v0[1]); w.y = pk2(v0[2], v0[3]); w.z = pk2(v1[0], v1[1]); w.w = pk2(v1[2], v1[3]);
                        *(u32x4*)(rowp + bj * HALF) = w; } }
            return;
        }
        const int ch0 = (u.pn >> 1) * 128 + (u.pn & 1) * 64 + wc * 16 + fq * 4;
        const f32x4 bq = *(const f32x4*)(b_in + ch0), bff = *(const f32x4*)(b_in + 1024 + ch0), bfb = *(const f32x4*)(b_in + 2048 + ch0), bvv = *(const f32x4*)(b_in + 3072 + ch0);
        f32x4 lbf, lbb;
        { const f32x4 a0 = *(const f32x4*)(lbl + ch0), a1 = *(const f32x4*)(lbl + 2048 + ch0), c0 = *(const f32x4*)(lbl + 1024 + ch0), c1 = *(const f32x4*)(lbl + 3072 + ch0);
#pragma unroll
          for (int e = 0; e < 4; ++e) { lbf[e] = __builtin_amdgcn_rcpf(1.f + fexp(a1[e] - a0[e])); lbb[e] = __builtin_amdgcn_rcpf(1.f + fexp(c1[e] - c0[e])); } }
#pragma unroll
        for (int ai = 0; ai < 2; ++ai) {
            const int chunk = (u.pm * BM + ai * HALF + wr * 64) >> 6;
#pragma unroll
            for (int ep = 0; ep < 2; ++ep) {
                float q[2][4], lf[2][4], lb_[2][4], kf[2][4], kb[2][4], totb[2];
#pragma unroll
                for (int e2 = 0; e2 < 2; ++e2) {
                    const int e = 2 * ep + e2;
                    float tf = 0.f, tb = 0.f;
#pragma unroll
                    for (int m = 0; m < 4; ++m) {
                        const float zq = acc[ai][0][m][0][e] + bq[e], zf = acc[ai][0][m][1][e] + bff[e], zb = acc[ai][1][m][0][e] + bfb[e];
                        q[e2][m] = fsilu(zq) * 0.08838834764831845f;
                        const float ef = fexp(-zf), sf = __builtin_amdgcn_rcpf(1.f + ef);
                        const float eb = fexp(-zb), sb = __builtin_amdgcn_rcpf(1.f + eb);
                        lf[e2][m] = flog(lbf[e] + (1.f - lbf[e]) * sf); kf[e2][m] = (1.f - lbf[e]) * (ef * sf);
                        lb_[e2][m] = flog(lbb[e] + (1.f - lbb[e]) * sb); kb[e2][m] = (1.f - lbb[e]) * (eb * sb);
                        tf += lf[e2][m]; tb += lb_[e2][m];
                    }
                    tf = rowsum16(tf); tb = rowsum16(tb); totb[e2] = tb;
                    if (fr == 0) { const unsigned od = ((unsigned)chunk * DM + ch0 + e) * 4u; *(float*)((unsigned char*)Ddf + od) = fexp(tf); *(float*)((unsigned char*)Ddb + od) = fexp(tb); }
                }
                __builtin_amdgcn_sched_barrier(0);
                float cf[2] = {0.f, 0.f}, cb[2] = {0.f, 0.f};
#pragma unroll
                for (int m = 0; m < 4; ++m) {
                    float oqf[2], okf[2], oqb[2], okb[2];
#pragma unroll
                    for (int e2 = 0; e2 < 2; ++e2) {
                        const float gf = rowscan16(lf[e2][m]) + cf[e2];
                        const float pbv = rowscan16(lb_[e2][m]) + cb[e2];
                        const float gb = totb[e2] - pbv + lb_[e2][m];
                        cf[e2] += rowsum16(lf[e2][m]); cb[e2] += rowsum16(lb_[e2][m]);
                        const float egf = fexp(gf), egb = fexp(gb);
                        oqf[e2] = q[e2][m] * egf; okf[e2] = kf[e2][m] * __builtin_amdgcn_rcpf(egf);
                        oqb[e2] = q[e2][m] * egb; okb[e2] = kb[e2][m] * __builtin_amdgcn_rcpf(egb);
                    }
                    const unsigned o = ((unsigned)(row0 + ai * HALF + m * 16) * DM + ch0 + 2 * ep) * 2u;
                    *(unsigned*)((unsigned char*)QDf + o) = pk2(oqf[0], oqf[1]); *(unsigned*)((unsigned char*)KIf + o) = pk2(okf[0], okf[1]);
                    *(unsigned*)((unsigned char*)QDb + o) = pk2(oqb[0], oqb[1]); *(unsigned*)((unsigned char*)KIb + o) = pk2(okb[0], okb[1]);
                    __builtin_amdgcn_sched_barrier(0);
                }
            }
#pragma unroll
            for (int m = 0; m < 4; ++m) {
                const unsigned o = ((unsigned)(row0 + ai * HALF + m * 16) * DM + ch0) * 2u;
                const f32x4 vv = acc[ai][1][m][1] + bvv;
                *(u32x2*)((unsigned char*)V + o) = (u32x2){pk2(vv[0], vv[1]), pk2(vv[2], vv[3])};
            }
        }
    }
};
struct EpiGate {
    static constexpr bool PERM = false, AFTER_DRAIN = false;
    bf16_t *A1, *A2, *S7, *S8; const bf16_t *ON, *HF, *HB; const float* b_in;
    __device__ __forceinline__ void operator()(const f32x4 (&acc)[2][2][4][2], const Unit& u, int wr, int wc, int fr_, int fq_) const {
        const int ln_ = lane_now(), fr = ln_ & 15, fq = ln_ >> 4;
        const int grp = u.pn >> 2, row0 = u.pm * BM + wr * 64 + fr, chb = (u.pn & 3) * 256 + wc * 32 + 8 * fq;
        const int boff = (grp == 0 ? 4096 : grp == 1 ? 6144 : grp == 2 ? 7168 : 8192) + chb;
        bf16_t* O = grp == 0 ? A1 : grp == 1 ? A2 : grp == 2 ? S7 : S8;
        f32x4 bv[2][2];
#pragma unroll
        for (int bj = 0; bj < 2; ++bj)
#pragma unroll
            for (int n = 0; n < 2; ++n) bv[bj][n] = *(const f32x4*)(b_in + boff + bj * HALF + 4 * n);
#pragma unroll
        for (int ai = 0; ai < 2; ++ai)
#pragma unroll
            for (int m = 0; m < 4; ++m) { const size_t ro = (size_t)(row0 + ai * HALF + m * 16) * DM + chb;
#pragma unroll
                for (int bj = 0; bj < 2; ++bj) { const f32x4 v0 = acc[ai][bj][m][0] + bv[bj][0], v1 = acc[ai][bj][m][1] + bv[bj][1];
                    float r[8];
                    if (grp >= 2) {
#pragma unroll
                        for (int j = 0; j < 4; ++j) { r[j] = fsig(v0[j]); r[4 + j] = fsig(v1[j]); }
                    } else {
                        float a[8];
                        if (grp == 0) { const u32x4 x = *(const u32x4*)(ON + ro + bj * HALF);
                            a[0] = bflo(x.x); a[1] = bfhi(x.x); a[2] = bflo(x.y); a[3] = bfhi(x.y); a[4] = bflo(x.z); a[5] = bfhi(x.z); a[6] = bflo(x.w); a[7] = bfhi(x.w);
                        } else { const u32x4 x = *(const u32x4*)(HF + ro + bj * HALF), y = *(const u32x4*)(HB + ro + bj * HALF);
                            a[0] = bflo(x.x) + bflo(y.x); a[1] = bfhi(x.x) + bfhi(y.x); a[2] = bflo(x.y) + bflo(y.y); a[3] = bfhi(x.y) + bfhi(y.y);
                            a[4] = bflo(x.z) + bflo(y.z); a[5] = bfhi(x.z) + bfhi(y.z); a[6] = bflo(x.w) + bflo(y.w); a[7] = bfhi(x.w) + bfhi(y.w); }
#pragma unroll
                        for (int j = 0; j < 4; ++j) { r[j] = a[j] * fsilu(v0[j]); r[4 + j] = a[4 + j] * fsilu(v1[j]); }
                    }
                    u32x4 w; w.x = pk2(r[0], r[1]); w.y = pk2(r[2], r[3]); w.z = pk2(r[4], r[5]); w.w = pk2(r[6], r[7]);
                    *(u32x4*)(O + ro + bj * HALF) = w; } }
    }
};
template <int MODE> struct EpiY {
    static constexpr bool PERM = false, AFTER_DRAIN = false;
    bf16_t* O; const bf16_t* S; const bf16_t* YA;
    __device__ __forceinline__ void operator()(const f32x4 (&acc)[2][2][4][2], const Unit& u, int wr, int wc, int fr_, int fq_) const {
        const int ln_ = lane_now(), fr = ln_ & 15, fq = ln_ >> 4;
        const int row0 = u.pm * BM + wr * 64 + fr, chb = u.pn * 256 + wc * 32 + 8 * fq;
#pragma unroll
        for (int ai = 0; ai < 2; ++ai)
#pragma unroll
            for (int m = 0; m < 4; ++m) { const size_t ro = (size_t)(row0 + ai * HALF + m * 16) * DM + chb;
#pragma unroll
                for (int bj = 0; bj < 2; ++bj) { const f32x4 v0 = acc[ai][bj][m][0], v1 = acc[ai][bj][m][1];
                    const u32x4 s = *(const u32x4*)(S + ro + bj * HALF);
                    float r[8] = {bflo(s.x) * v0[0], bfhi(s.x) * v0[1], bflo(s.y) * v0[2], bfhi(s.y) * v0[3], bflo(s.z) * v1[0], bfhi(s.z) * v1[1], bflo(s.w) * v1[2], bfhi(s.w) * v1[3]};
                    if (MODE == 1) { const u32x4 y = *(const u32x4*)(YA + ro + bj * HALF);
                        r[0] += bflo(y.x); r[1] += bfhi(y.x); r[2] += bflo(y.y); r[3] += bfhi(y.y); r[4] += bflo(y.z); r[5] += bfhi(y.z); r[6] += bflo(y.w); r[7] += bfhi(y.w); }
                    u32x4 w; w.x = pk2(r[0], r[1]); w.y = pk2(r[2], r[3]); w.z = pk2(r[4], r[5]); w.w = pk2(r[6], r[7]);
                    *(u32x4*)(O + ro + bj * HALF) = w; } }
    }
};
struct EpiPre {
    static constexpr bool PERM = false, AFTER_DRAIN = false;
    const float* x; float* out; const float* gt;
    __device__ __forceinline__ void operator()(const f32x4 (&acc)[2][2][4][2], const Unit& u, int wr, int wc, int fr_, int fq_) const {
        const int ln_ = lane_now(), fr = ln_ & 15, fq = ln_ >> 4;
        const int row0 = u.pm * BM + wr * 64 + fr, col0 = u.pn * BM + wc * 32 + 4 * fq, b = (u.pm * BM) >> 13;
        f32x4 gv[2][2];
#pragma unroll
        for (int bj = 0; bj < 2; ++bj)
#pragma unroll
            for (int n = 0; n < 2; ++n) gv[bj][n] = *(const f32x4*)(gt + b * DM + col0 + bj * HALF + n * 16);
#pragma unroll
        for (int ai = 0; ai < 2; ++ai)
#pragma unroll
            for (int m = 0; m < 4; ++m) { const size_t ro = (size_t)(row0 + ai * HALF + m * 16) * DM + col0;
#pragma unroll
                for (int bj = 0; bj < 2; ++bj)
#pragma unroll
                    for (int n = 0; n < 2; ++n) { const f32x4 xv = *(const f32x4*)(x + ro + bj * HALF + n * 16);
                        *(f32x4*)(out + ro + bj * HALF + n * 16) = xv * 1.189207115f + gv[bj][n] * acc[ai][bj][m][n]; } }
    }
};
}

namespace mix {
__device__ __forceinline__ unsigned off_b(unsigned row, unsigned ch) { return 256u * row + 16u * (ch ^ (((row & 3u) << 2) | ((row >> 2) & 3u))); }
__device__ __forceinline__ unsigned off_p(unsigned row, unsigned ch) { return 128u * row + 16u * (ch ^ ((row >> 1) & 7u)); }
__device__ __forceinline__ unsigned rr16(unsigned lane, unsigned rb, unsigned s) { return off_b((lane & 15u) + 16u * rb, 4u * s + (lane >> 4)); }
__device__ __forceinline__ unsigned rr32(unsigned lane, unsigned rb, unsigned s) { return off_b(32u * rb + (lane & 31u), 2u * s + (lane >> 5)); }
__device__ __forceinline__ unsigned rr32p(unsigned lane, unsigned rb, unsigned s) { return off_p(32u * rb + (lane & 31u), 2u * s + (lane >> 5)); }
__device__ __forceinline__ unsigned tr32(unsigned lane, unsigned c, unsigned ks, unsigned t) {
    const unsigned h = lane >> 5, blk = (lane >> 4) & 1u, q = (lane & 15u) >> 2, p = lane & 3u;
    return off_b(16u * ks + 8u * h + 4u * t + q, 4u * c + 2u * blk + (p >> 1)) + 8u * (p & 1u);
}
typedef short v4i16_t __attribute__((ext_vector_type(4)));
__device__ __forceinline__ bf16x8 ld128(const LAS unsigned char* base, unsigned off) { return *(const LAS bf16x8*)(base + off); }
__device__ __forceinline__ bf16x8 ldtr(const LAS unsigned char* base, unsigned off0, unsigned off1) {
    const v4i16_t lo = __builtin_amdgcn_ds_read_tr16_b64_v4i16((LAS v4i16_t*)(base + off0)), hi = __builtin_amdgcn_ds_read_tr16_b64_v4i16((LAS v4i16_t*)(base + off1));
    return (bf16x8){lo[0], lo[1], lo[2], lo[3], hi[0], hi[1], hi[2], hi[3]};
}
#define MFMA32(a, b, c) __builtin_amdgcn_mfma_f32_32x32x16_bf16((a), (b), (c), 0, 0, 0)
#define MFMA16(a, b, c) __builtin_amdgcn_mfma_f32_16x16x32_bf16((a), (b), (c), 0, 0, 0)
#define WG_BAR() do { asm volatile("s_waitcnt vmcnt(0) lgkmcnt(0)" ::: "memory"); __builtin_amdgcn_s_barrier(); asm volatile("" ::: "memory"); } while (0)
#define WG_BAR_L() do { asm volatile("s_waitcnt lgkmcnt(0)" ::: "memory"); __builtin_amdgcn_s_barrier(); asm volatile("" ::: "memory"); } while (0)

constexpr unsigned G_TILE = 16384, G_P = 6 * G_TILE, G_ST = G_P + 8192, G_END = G_ST + 32768;
static_assert(G_END == 139264, "gla lds");
__device__ __forceinline__ void gla_wg(LAS unsigned char* lds, int b, int h, int dir, bf16_t* QD, const bf16_t* KI, const bf16_t* V, const float* Dd) {
    const unsigned tid = threadIdx.x, lane = tid & 63u, hh = lane >> 5;
    const int w = __builtin_amdgcn_readfirstlane((int)(tid >> 6));
    const int cb = w & 1, jb = w >> 1;
    const int cb16 = w >> 1, sbp = 2 * (w & 1);
    for (unsigned i = tid; i < 32768u / 16u; i += NTHR) *(LAS u32x4*)(lds + G_ST + 16u * i) = (u32x4){0u, 0u, 0u, 0u};
    f32x16 sacc[2];
#pragma unroll
    for (int i = 0; i < 2; ++i)
#pragma unroll
        for (int r = 0; r < 16; ++r) sacc[i][r] = 0.f;
    const unsigned lrow = tid >> 3, lch = 2u * (tid & 7u);
    const size_t hoff = (size_t)h * 128;
    u32x4 nq[2], nk[2], nv[2]; f32x4 nd[2][4], cd[2][4];
    auto chunk_base = [&](int n) -> int { return n < 4 ? (LROWS + b * TC + 64 * (dir ? 3 - n : n)) : (b * TL + 64 * (dir ? 127 - (n - 4) : (n - 4))); };
#define GLA_ISSUE(n) do { const int base_ = chunk_base(n); const size_t go_ = (size_t)(base_ + (dir ? 63 - (int)lrow : (int)lrow)) * DM + hoff + lch * 8; \
        nq[0] = *(const u32x4*)(QD + go_); nq[1] = *(const u32x4*)(QD + go_ + 8); nk[0] = *(const u32x4*)(KI + go_); nk[1] = *(const u32x4*)(KI + go_ + 8); \
        nv[0] = *(const u32x4*)(V + go_); nv[1] = *(const u32x4*)(V + go_ + 8); \
        _Pragma("unroll") for (int i_ = 0; i_ < 2; ++i_) _Pragma("unroll") for (int g_ = 0; g_ < 4; ++g_) \
            nd[i_][g_] = *(const f32x4*)(Dd + (size_t)(base_ >> 6) * DM + hoff + 32 * (2 * cb + i_) + 8 * g_ + 4 * hh); } while (0)
#define GLA_WRITE(buf) do { LAS unsigned char* t_ = lds + (buf) * 3u * G_TILE; \
        *(LAS u32x4*)(t_ + off_b(lrow, lch)) = nq[0]; *(LAS u32x4*)(t_ + off_b(lrow, lch + 1)) = nq[1]; \
        *(LAS u32x4*)(t_ + G_TILE + off_b(lrow, lch)) = nk[0]; *(LAS u32x4*)(t_ + G_TILE + off_b(lrow, lch + 1)) = nk[1]; \
        *(LAS u32x4*)(t_ + 2u * G_TILE + off_b(lrow, lch)) = nv[0]; *(LAS u32x4*)(t_ + 2u * G_TILE + off_b(lrow, lch + 1)) = nv[1]; } while (0)
    GLA_ISSUE(0);
    GLA_WRITE(0);
#pragma unroll
    for (int i = 0; i < 2; ++i)
#pragma unroll
        for (int g = 0; g < 4; ++g) cd[i][g] = nd[i][g];
    GLA_ISSUE(1);
    WG_BAR_L();
    const LAS unsigned char* Pm = lds + G_P; const LAS unsigned char* ST = lds + G_ST;
    for (int n = 0; n < 132; ++n) {
        const unsigned cur = (unsigned)n & 1u;
        const LAS unsigned char* qd = lds + cur * 3u * G_TILE; const LAS unsigned char* ki = qd + G_TILE; const LAS unsigned char* vv = qd + 2u * G_TILE;
        const bool latent = n >= 4;
        f32x16 oacc;
#pragma unroll
        for (int r = 0; r < 16; ++r) oacc[r] = 0.f;
        if (latent) {
            bf16x8 qf[4];
#pragma unroll
            for (int s = 0; s < 4; ++s) qf[s] = ld128(qd, rr16(lane, cb16, s));
#pragma unroll
            for (int i = 0; i < 2; ++i) {
                const int sb = sbp + i;
                f32x4 a = (f32x4){0.f, 0.f, 0.f, 0.f};
                if (sb <= cb16) {
#pragma unroll
                    for (int s = 0; s < 4; ++s) a = MFMA16(ld128(ki, rr16(lane, sb, s)), qf[s], a);
                }
                const int c = 16 * cb16 + (int)(lane & 15u), s0 = 16 * sb + 4 * (int)(lane >> 4);
                float r[4];
#pragma unroll
                for (int e = 0; e < 4; ++e) r[e] = (s0 + e <= c) ? a[e] : 0.f;
                *(LAS u32x2*)(lds + G_P + off_p((unsigned)c, (unsigned)(2 * sb) + (lane >> 5)) + 8u * ((lane >> 4) & 1u)) = (u32x2){pk2(r[0], r[1]), pk2(r[2], r[3])};
            }
#pragma unroll
            for (int s = 0; s < 8; ++s) oacc = MFMA32(ld128(ST, rr32(lane, jb, s)), ld128(qd, rr32(lane, cb, s)), oacc);
        }
        WG_BAR_L();
        bf16x8 vf[4];
#pragma unroll
        for (int ks = 0; ks < 4; ++ks) vf[ks] = ldtr(vv, tr32(lane, jb, ks, 0), tr32(lane, jb, ks, 1));
        if (latent) {
#pragma unroll
            for (int ks = 0; ks < 4; ++ks) oacc = MFMA32(vf[ks], ld128(Pm, rr32p(lane, cb, ks)), oacc);
            const int c = 32 * cb + (int)(lane & 31u);
            bf16_t* orow = QD + (size_t)(chunk_base(n) + (dir ? 63 - c : c)) * DM + hoff + 32 * jb + 4 * hh;
#pragma unroll
            for (int g = 0; g < 4; ++g) *(u32x2*)(orow + 8 * g) = (u32x2){pk2(oacc[4 * g], oacc[4 * g + 1]), pk2(oacc[4 * g + 2], oacc[4 * g + 3])};
        }
#pragma unroll
        for (int i = 0; i < 2; ++i) {
            const int chb = 2 * cb + i;
#pragma unroll
            for (int ks = 0; ks < 4; ++ks) sacc[i] = MFMA32(ldtr(ki, tr32(lane, chb, ks, 0), tr32(lane, chb, ks, 1)), vf[ks], sacc[i]);
#pragma unroll
            for (int g = 0; g < 4; ++g) {
#pragma unroll
                for (int e = 0; e < 4; ++e) sacc[i][4 * g + e] *= cd[i][g][e];
                *(LAS u32x2*)(lds + G_ST + off_b(32u * jb + (lane & 31u), (unsigned)(4 * chb + g)) + 8u * hh) = (u32x2){pk2(sacc[i][4 * g], sacc[i][4 * g + 1]), pk2(sacc[i][4 * g + 2], sacc[i][4 * g + 3])};
            }
        }
        if (n + 1 < 132) {
            asm volatile("s_waitcnt vmcnt(0)" ::: "memory");
            GLA_WRITE(cur ^ 1u);
#pragma unroll
            for (int i = 0; i < 2; ++i)
#pragma unroll
                for (int g = 0; g < 4; ++g) cd[i][g] = nd[i][g];
            if (n + 2 < 132) GLA_ISSUE(n + 2);
        }
        WG_BAR_L();
    }
    asm volatile("s_waitcnt vmcnt(0)" ::: "memory");
#undef GLA_ISSUE
#undef GLA_WRITE
}

__device__ __forceinline__ void rglru_wg(LAS unsigned char* lds, int b, int g, int dir, const bf16_t* X5, const float* conv_w, const float* conv_b, const bf16_t* Wg,
                                         const float* b_r, const float* b_i, const float* lam, bf16_t* Hout) {
    const unsigned tid = threadIdx.x, lane = tid & 63u, fr = lane & 15u, fq = lane >> 4;
    const int w = __builtin_amdgcn_readfirstlane((int)(tid >> 6));
    const unsigned cidx = tid & 15u, arow = tid >> 4;
    float cw[4][8], cbv[8];
    { const int chg = g * 128 + (int)cidx * 8;
#pragma unroll
      for (int k = 0; k < 4; ++k) { const f32x4 a0 = *(const f32x4*)(conv_w + k * DM + chg), a1 = *(const f32x4*)(conv_w + k * DM + chg + 4);
          cw[k][0] = a0[0]; cw[k][1] = a0[1]; cw[k][2] = a0[2]; cw[k][3] = a0[3]; cw[k][4] = a1[0]; cw[k][5] = a1[1]; cw[k][6] = a1[2]; cw[k][7] = a1[3]; }
      const f32x4 c0 = *(const f32x4*)(conv_b + chg), c1 = *(const f32x4*)(conv_b + chg + 4);
      cbv[0] = c0[0]; cbv[1] = c0[1]; cbv[2] = c0[2]; cbv[3] = c0[3]; cbv[4] = c1[0]; cbv[5] = c1[1]; cbv[6] = c1[2]; cbv[7] = c1[3]; }
    bf16x8 wrf[4], wif[4];
    { const bf16_t* wb = Wg + (size_t)((dir * 8 + g) * 2) * 16384 + (size_t)(16 * w + (int)fr) * 128 + 8 * fq;
#pragma unroll
      for (int s = 0; s < 4; ++s) { wrf[s] = *(const bf16x8*)(wb + 32 * s); wif[s] = *(const bf16x8*)(wb + 16384 + 32 * s); } }
    const int chl = g * 128 + 16 * w + 4 * (int)fq;
    const f32x4 brv = *(const f32x4*)(b_r + dir * DM + chl), biv = *(const f32x4*)(b_i + dir * DM + chl);
    f32x4 c1v;
    { const f32x4 lm = *(const f32x4*)(lam + dir * DM + chl);
#pragma unroll
      for (int e = 0; e < 4; ++e) c1v[e] = -8.f * log1pf(__expf(-lm[e])); }
    f32x4 hc = (f32x4){0.f, 0.f, 0.f, 0.f};
    u32x4 ld7[7];
    auto seq = [&](int it, int& base_row, int& stride, int& seqlen, int& pos0, bool& emit) {
        if (it < 2) { const int hf = dir ? 1 - it : it; base_row = LROWS + b * TC; stride = 1; seqlen = TC; pos0 = 128 * hf; emit = false; }
        else { const int col = dir ? 63 - (it - 2) : (it - 2); base_row = b * TL + col; stride = 64; seqlen = 128; pos0 = 0; emit = true; }
    };
#define RG_ISSUE(it) do { int br_, st_, sl_, p0_; bool em_; seq((it), br_, st_, sl_, p0_, em_); \
        _Pragma("unroll") for (int k_ = 0; k_ < 7; ++k_) { const int pos_ = p0_ + 4 * (int)arow + k_ - 1; \
            ld7[k_] = (pos_ >= 0 && pos_ < sl_) ? *(const u32x4*)(X5 + (size_t)(br_ + pos_ * st_) * DM + g * 128 + cidx * 8) : (u32x4){0u, 0u, 0u, 0u}; } } while (0)
#define RG_CONV(buf) do { LAS unsigned char* xi_ = lds + (buf) * 32768u; \
        _Pragma("unroll") for (int r_ = 0; r_ < 4; ++r_) { float o_[8]; \
            _Pragma("unroll") for (int e_ = 0; e_ < 8; ++e_) o_[e_] = cbv[e_]; \
            _Pragma("unroll") for (int k_ = 0; k_ < 4; ++k_) { const u32x4 x_ = ld7[r_ + k_]; \
                o_[0] += cw[k_][0] * bflo(x_.x); o_[1] += cw[k_][1] * bfhi(x_.x); o_[2] += cw[k_][2] * bflo(x_.y); o_[3] += cw[k_][3] * bfhi(x_.y); \
                o_[4] += cw[k_][4] * bflo(x_.z); o_[5] += cw[k_][5] * bfhi(x_.z); o_[6] += cw[k_][6] * bflo(x_.w); o_[7] += cw[k_][7] * bfhi(x_.w); } \
            *(LAS u32x4*)(xi_ + off_b(4u * arow + (unsigned)r_, cidx)) = (u32x4){pk2(o_[0], o_[1]), pk2(o_[2], o_[3]), pk2(o_[4], o_[5]), pk2(o_[6], o_[7])}; } } while (0)
    RG_ISSUE(0);
    RG_CONV(0);
    WG_BAR_L();
    for (int it = 0; it < 66; ++it) {
        const unsigned cur = (unsigned)it & 1u;
        const LAS unsigned char* xi = lds + cur * 32768u;
        if (it + 1 < 66) RG_ISSUE(it + 1);
        int base_row, stride, seqlen, pos0; bool emit; seq(it, base_row, stride, seqlen, pos0, emit);
        f32x4 racc[8], iacc[8];
#pragma unroll
        for (int mb = 0; mb < 8; ++mb) {
            racc[mb] = (f32x4){0.f, 0.f, 0.f, 0.f}; iacc[mb] = (f32x4){0.f, 0.f, 0.f, 0.f};
#pragma unroll
            for (int s = 0; s < 4; ++s) { const bf16x8 xf = ld128(xi, rr16(lane, (unsigned)mb, (unsigned)s)); racc[mb] = MFMA16(wrf[s], xf, racc[mb]); iacc[mb] = MFMA16(wif[s], xf, iacc[mb]); }
        }
#pragma unroll
        for (int mm = 0; mm < 8; ++mm) {
            const int mb = dir ? 7 - mm : mm;
            const u32x2 xr = *(const LAS u32x2*)(xi + off_b(16u * (unsigned)mb + fr, 2u * (unsigned)w + (fq >> 1)) + 8u * (fq & 1u));
            const float xc[4] = {bflo(xr.x), bfhi(xr.x), bflo(xr.y), bfhi(xr.y)};
            f32x4 hv;
#pragma unroll
            for (int e = 0; e < 4; ++e) {
                const float rg = fsig(racc[mb][e] + brv[e]), ig = fsig(iacc[mb][e] + biv[e]);
                const float la = rg * c1v[e];
                float A = __expf(la);
                float B = sqrtf(fmaxf(1.f - __expf(2.f * la), 0.f)) * ig * xc[e];
                if (!dir) {
#pragma unroll
                    for (int d = 1; d < 16; d <<= 1) { const float ap = __shfl_up(A, d, 16), bp = __shfl_up(B, d, 16); if ((int)fr >= d) { B = A * bp + B; A = A * ap; } }
                } else {
#pragma unroll
                    for (int d = 1; d < 16; d <<= 1) { const float ap = __shfl_down(A, d, 16), bp = __shfl_down(B, d, 16); if ((int)fr + d < 16) { B = A * bp + B; A = A * ap; } }
                }
                const float hval = A * hc[e] + B;
                hc[e] = __shfl(hval, dir ? 0 : 15, 16);
                hv[e] = hval;
            }
            if (emit) {
                const int pos = pos0 + 16 * mb + (int)fr;
                *(u32x2*)(Hout + (size_t)(base_row + pos * stride) * DM + chl) = (u32x2){pk2(hv[0], hv[1]), pk2(hv[2], hv[3])};
            }
        }
        if (it + 1 < 66) { asm volatile("s_waitcnt vmcnt(0)" ::: "memory"); RG_CONV(cur ^ 1u); }
        WG_BAR_L();
    }
    asm volatile("s_waitcnt vmcnt(0)" ::: "memory");
#undef RG_ISSUE
#undef RG_CONV
}
}

__device__ __forceinline__ void norm_row(bf16_t* Of, const bf16_t* Ob, const float* gn, int lane) {
    const u32x4 a0 = *(const u32x4*)(Of + 16 * lane), a1 = *(const u32x4*)(Of + 16 * lane + 8), b0 = *(const u32x4*)(Ob + 16 * lane), b1 = *(const u32x4*)(Ob + 16 * lane + 8);
    float v[16] = {bflo(a0.x) + bflo(b0.x), bfhi(a0.x) + bfhi(b0.x), bflo(a0.y) + bflo(b0.y), bfhi(a0.y) + bfhi(b0.y), bflo(a0.z) + bflo(b0.z), bfhi(a0.z) + bfhi(b0.z), bflo(a0.w) + bflo(b0.w), bfhi(a0.w) + bfhi(b0.w),
                   bflo(a1.x) + bflo(b1.x), bfhi(a1.x) + bfhi(b1.x), bflo(a1.y) + bflo(b1.y), bfhi(a1.y) + bfhi(b1.y), bflo(a1.z) + bflo(b1.z), bfhi(a1.z) + bfhi(b1.z), bflo(a1.w) + bflo(b1.w), bfhi(a1.w) + bfhi(b1.w)};
    float ss = 0.f;
#pragma unroll
    for (int i = 0; i < 16; ++i) ss += v[i] * v[i];
    ss += __shfl_xor(ss, 1); ss += __shfl_xor(ss, 2); ss += __shfl_xor(ss, 4);
    const float rs = rsqrtf(ss * (1.f / 128.f) + 1e-6f);
    const float* gp = gn + 16 * (lane & 7);
    u32x4 o0, o1;
    o0.x = pk2(v[0] * rs * gp[0], v[1] * rs * gp[1]); o0.y = pk2(v[2] * rs * gp[2], v[3] * rs * gp[3]); o0.z = pk2(v[4] * rs * gp[4], v[5] * rs * gp[5]); o0.w = pk2(v[6] * rs * gp[6], v[7] * rs * gp[7]);
    o1.x = pk2(v[8] * rs * gp[8], v[9] * rs * gp[9]); o1.y = pk2(v[10] * rs * gp[10], v[11] * rs * gp[11]); o1.z = pk2(v[12] * rs * gp[12], v[13] * rs * gp[13]); o1.w = pk2(v[14] * rs * gp[14], v[15] * rs * gp[15]);
    *(u32x4*)(Of + 16 * lane) = o0; *(u32x4*)(Of + 16 * lane + 8) = o1;
}
__device__ __forceinline__ float wave_sum(float v) {
#pragma unroll
    for (int o = 1; o < 64; o <<= 1) v += __shfl_xor(v, o);
    return v;
}
__device__ __forceinline__ void ln_row(float* row, const float* g, const float* bta, int lane) {
    f32x4* p = (f32x4*)row + lane;
    f32x4 v[4]; float s = 0.f;
#pragma unroll
    for (int j = 0; j < 4; ++j) { v[j] = p[64 * j]; s += (v[j].x + v[j].y) + (v[j].z + v[j].w); }
    const float mean = wave_sum(s) * (1.f / DM); float q = 0.f;
#pragma unroll
    for (int j = 0; j < 4; ++j) { v[j] = v[j] - mean; q += (v[j].x * v[j].x + v[j].y * v[j].y) + (v[j].z * v[j].z + v[j].w * v[j].w); }
    const float rstd = rsqrtf(wave_sum(q) * (1.f / DM) + 1e-5f);
#pragma unroll
    for (int j = 0; j < 4; ++j) { const f32x4 gg = ((const f32x4*)g)[lane + 64 * j], bb = ((const f32x4*)bta)[lane + 64 * j]; p[64 * j] = v[j] * rstd * gg + bb; }
}

namespace cg = cooperative_groups;
#ifndef MK_SINGLE
#define MK_SINGLE 1
#endif
constexpr int N_PHASES = 9;
#ifndef DBG_STOP
#define DBG_STOP 99
#endif
__global__ void dbg_hsum(const bf16_t* hf, const bf16_t* hb, float* tmp) { const size_t i = (size_t)blockIdx.x * 256 + threadIdx.x; tmp[i] = bf2f(hf[i]) + bf2f(hb[i]); }
__global__ void dbg_copy(const float* tmp, float* out) { const size_t i = (size_t)blockIdx.x * 256 + threadIdx.x; out[i] = tmp[i]; }
__global__ void dbg_dump(const bf16_t* a0, const bf16_t* a1, const bf16_t* a2, const bf16_t* a3, const bf16_t* a4, const bf16_t* a5, float* out) {
    const size_t i = (size_t)blockIdx.x * 256 + threadIdx.x; float s = 0.f;
    if (a0) s += bf2f(a0[i]); if (a1) s += bf2f(a1[i]); if (a2) s += bf2f(a2[i]); if (a3) s += bf2f(a3[i]); if (a4) s += bf2f(a4[i]); if (a5) s += bf2f(a5[i]);
    out[i] = s;
}
struct Args { const float* in[22]; float* out; unsigned char* ws; int ph_lo, ph_hi; };
__global__ void __launch_bounds__(NTHR, 2) fwd_kernel(Args a) {
    extern __shared__ __attribute__((aligned(16))) unsigned char lds_raw[];
    LAS unsigned char* lds = (LAS unsigned char*)lds_raw;
    const int tid = threadIdx.x, lane = tid & 63, wave = __builtin_amdgcn_readfirstlane(tid >> 6);
    const int G = gridDim.x, bx = blockIdx.x;
    const int vcu = (G % 8 == 0) ? (bx % 8) * (G / 8) + bx / 8 : bx;
    const int gw = vcu * NWAVES + wave, NGW = G * NWAVES;
    unsigned char* ws = a.ws;
    const float *x = a.in[0], *cvec = a.in[1], *ctx = a.in[2], *c_ctx = a.in[3], *w_mod = a.in[4], *b_mod = a.in[5], *w_in = a.in[6], *b_in = a.in[7], *lbl = a.in[8], *norm_g = a.in[9],
                *conv_w = a.in[10], *conv_b = a.in[11], *w_r = a.in[12], *b_r = a.in[13], *w_i = a.in[14], *b_i = a.in[15], *lam = a.in[16], *p_a = a.in[17], *p_b = a.in[18], *w_out = a.in[19],
                *ln_g = a.in[20], *ln_b = a.in[21];
    float* out = a.out;
    bf16_t* Wt_in = (bf16_t*)(ws + WS_WIN); bf16_t* Wt_pa = (bf16_t*)(ws + WS_WPA); bf16_t* Wt_pb = (bf16_t*)(ws + WS_WPB); bf16_t* Wt_out = (bf16_t*)(ws + WS_WOUT); bf16_t* Wg = (bf16_t*)(ws + WS_WG);
    float* modp = (float*)(ws + WS_MODP); float* gtv = (float*)(ws + WS_GT); float* Ddf = (float*)(ws + WS_DDF); float* Ddb = (float*)(ws + WS_DDB);
#define SLOTP(i) ((bf16_t*)(ws + WS_SLOTS + (size_t)(i) * SLOT))
    bf16_t *U = SLOTP(SL_U), *QDf = SLOTP(SL_QDF), *KIf = SLOTP(SL_KIF), *QDb = SLOTP(SL_QDB), *KIb = SLOTP(SL_KIB), *Vv = SLOTP(SL_V), *X5 = SLOTP(SL_X5);
    bf16_t* Hf = (bf16_t*)out; bf16_t* Hb = Hf + (size_t)LROWS * DM;
    bf16_t *A1 = KIf, *A2 = KIb, *S7 = Vv, *S8 = QDb, *YA = U, *Y = X5;
    cg::grid_group grid = cg::this_grid();
    const int lo = a.ph_lo, hi = a.ph_hi;
#define IN(k) (lo <= (k) && (k) < hi)
#define SEAM(k) do { if (IN(k) && IN((k) + 1)) { __syncthreads(); grid.sync(); } } while (0)

    if (IN(0)) {
        LAS float* scr = (LAS float*)(lds + wave * 16384);
        constexpr int I_MP = 192, I_WIN = 16 * 288, I_SQ = 16 * 32, I_G = 256, NIT = I_MP + I_WIN + 3 * I_SQ + I_G;
        for (int it = gw; it < NIT; it += NGW) {
            int r = it;
            if (r < I_MP) { modp_item(cvec, c_ctx, w_mod, modp, r, lane); continue; } r -= I_MP;
            if (r < I_WIN) { transpose_item<1>(w_in, DM, 9216, Wt_in, scr, r, lane); continue; } r -= I_WIN;
            if (r < I_SQ) { transpose_item<2>(p_a, DM, DM, Wt_pa, scr, r, lane); continue; } r -= I_SQ;
            if (r < I_SQ) { transpose_item<2>(p_b, DM, DM, Wt_pb, scr, r, lane); continue; } r -= I_SQ;
            if (r < I_SQ) { transpose_item<0>(w_out, DM, DM, Wt_out, scr, r, lane); continue; } r -= I_SQ;
            { const int mi = r >> 4, ty = (r >> 3) & 1, sub = r & 7;
              transpose_item<0>((ty ? w_i : w_r) + (size_t)mi * 16384, 128, 128, Wg + (size_t)(mi * 2 + ty) * 16384, scr, sub, lane); }
        }
    }
    SEAM(0);
    if (IN(1)) {
        LAS float* tabL = (LAS float*)lds; LAS float* tabC = tabL + 2048;
        for (int wgi = vcu; wgi < 256; wgi += G) {
            const int b = wgi >> 6;
            __syncthreads();
#pragma unroll
            for (int v = 0; v < 4; ++v) { const int col = tid + 512 * v; float sl = b_mod[col], sc = sl;
#pragma unroll 4
                for (int kc = 0; kc < 16; ++kc) { sl += modp[(size_t)(kc * 5 + b) * 3072 + col]; sc += modp[(size_t)(kc * 5 + 4) * 3072 + col]; }
                if (col >= 1024) { sl += 1.f; sc += 1.f; }
                tabL[col] = sl; tabC[col] = sc; }
            if (wgi < 4) {
#pragma unroll
                for (int v = 0; v < 2; ++v) { const int col = tid + 512 * v; float s = b_mod[2048 + col];
                    for (int kc = 0; kc < 16; ++kc) s += modp[(size_t)(kc * 5 + wgi) * 3072 + 2048 + col];
                    gtv[wgi * DM + col] = s; }
            }
            __syncthreads();
            for (int i = 0; i < 16; ++i) { const int row = wgi * 128 + wave + 8 * i; urow(x + (size_t)row * DM, U + (size_t)row * DM, tabL, lane); }
            if (wave < 4) { const int r2 = wgi * 4 + wave; urow(ctx + (size_t)r2 * DM, U + (size_t)(LROWS + r2) * DM, tabC, lane); }
        }
    }
    SEAM(1);
    if (IN(2)) {
        pg8::Gemm g{U, Wt_in, ROWS, 5120, DM}; pg8::StaticOrder S; S.init(ROWS, 5120, G, bx);
        epi::EpiMix E{QDf, KIf, QDb, KIb, Vv, X5, Ddf, Ddb, b_in, lbl};
        pg8::gemm_phase<epi::EpiMix, pg8::StaticOrder, true, true>(lds, g, S, E);
    }
    SEAM(2);
    if (IN(3)) {
        if (bx < 64) { const int b = bx >> 4, dir = (bx >> 3) & 1, h = bx & 7;
            mix::gla_wg(lds, b, h, dir, dir ? QDb : QDf, dir ? KIb : KIf, Vv, dir ? Ddb : Ddf);
        } else if (bx < 128) { const int i = bx - 64, b = i >> 4, dir = (i >> 3) & 1, g = i & 7;
            mix::rglru_wg(lds, b, g, dir, X5, conv_w, conv_b, Wg, b_r, b_i, lam, dir ? Hb : Hf);
        }
    }
    SEAM(3);
    if (IN(4)) {
        for (int row = gw; row < LROWS; row += NGW) norm_row(QDf + (size_t)row * DM, QDb + (size_t)row * DM, norm_g, lane);
    }
    SEAM(4);
    if (IN(5)) {
        pg8::Gemm g{U, Wt_in + (size_t)5120 * DM, LROWS, 4096, DM}; pg8::StaticOrder S; S.init(LROWS, 4096, G, bx);
        epi::EpiGate E{A1, A2, S7, S8, QDf, Hf, Hb, b_in};
        pg8::gemm_phase<epi::EpiGate, pg8::StaticOrder, true, true>(lds, g, S, E);
    }
    SEAM(5);
    if (IN(6)) {
        pg8::StaticOrder S; S.init(LROWS, DM, G, bx);
        { pg8::Gemm g{A1, Wt_pa, LROWS, DM, DM}; epi::EpiY<0> E{YA, S7, nullptr}; pg8::gemm_phase<epi::EpiY<0>, pg8::StaticOrder, true, true>(lds, g, S, E); }
        __syncthreads();
        { pg8::Gemm g{A2, Wt_pb, LROWS, DM, DM}; epi::EpiY<1> E{Y, S8, YA}; pg8::gemm_phase<epi::EpiY<1>, pg8::StaticOrder, true, true>(lds, g, S, E); }
    }
    SEAM(6);
    if (IN(7)) {
        pg8::Gemm g{Y, Wt_out, LROWS, DM, DM}; pg8::StaticOrder S; S.init(LROWS, DM, G, bx);
        epi::EpiPre E{x, out, gtv};
        pg8::gemm_phase<epi::EpiPre, pg8::StaticOrder, true, true>(lds, g, S, E);
    }
    SEAM(7);
    if (IN(8)) {
        for (int row = gw; row < LROWS; row += NGW) ln_row(out + (size_t)row * DM, ln_g, ln_b, lane);
    }
#undef IN
#undef SEAM
#undef SLOTP
}

extern "C" void kernel_launch(void* const* d_in, const int* in_sizes, int n_in, void* d_out, int out_size, void* d_ws, size_t ws_size, hipStream_t stream) {
    static int grid = 0;
    if (grid == 0) {
        int dev = 0, cus = 0, per_cu = 0;
        if (hipGetDevice(&dev) != hipSuccess || hipDeviceGetAttribute(&cus, hipDeviceAttributeMultiprocessorCount, dev) != hipSuccess) { fprintf(stderr, "kernel_launch: device query failed\n"); grid = -1; return; }
        if (hipFuncSetAttribute((const void*)fwd_kernel, hipFuncAttributeMaxDynamicSharedMemorySize, LDS_BYTES) != hipSuccess) { fprintf(stderr, "kernel_launch: hipFuncSetAttribute failed\n"); grid = -1; return; }
        if (hipOccupancyMaxActiveBlocksPerMultiprocessor(&per_cu, (const void*)fwd_kernel, NTHR, LDS_BYTES) != hipSuccess || per_cu < 1) { fprintf(stderr, "kernel_launch: occupancy query says %d\n", per_cu); per_cu = 1; }
        (void)hipGetLastError();
        grid = cus;
        if (ws_size < WS_END) { fprintf(stderr, "kernel_launch: workspace too small (%zu < %zu)\n", ws_size, (size_t)WS_END); grid = -1; return; }
    }
    if (grid < 0) return;
    Args a{};
    for (int i = 0; i < 22; ++i) a.in[i] = (const float*)d_in[i];
    a.out = (float*)d_out; a.ws = (unsigned char*)d_ws;
#if MK_SINGLE
    a.ph_lo = 0; a.ph_hi = N_PHASES;
    void* args[] = {&a};
    hipError_t e = hipLaunchCooperativeKernel((const void*)fwd_kernel, dim3(grid), dim3(NTHR), args, LDS_BYTES, stream);
    if (e != hipSuccess) fprintf(stderr, "cooperative launch failed: %s (grid %d)\n", hipGetErrorString(e), grid);
#else
    for (int p = 0; p < N_PHASES && p <= (DBG_STOP == 30 ? 3 : DBG_STOP); ++p) { a.ph_lo = p; a.ph_hi = p + 1; hipLaunchKernelGGL(fwd_kernel, dim3(grid), dim3(NTHR), LDS_BYTES, stream, a); }
#if DBG_STOP < 99
    { unsigned char* w = (unsigned char*)d_ws; auto SL = [&](int i) { return (const bf16_t*)(w + WS_SLOTS + (size_t)i * SLOT); };
      const bf16_t *p0 = nullptr, *p1 = nullptr, *p2 = nullptr, *p3 = nullptr, *p4 = nullptr, *p5 = nullptr;
      if (DBG_STOP == 1) { p0 = SL(SL_U); }
      if (DBG_STOP == 2) { p0 = SL(SL_QDF); p1 = SL(SL_KIF); p2 = SL(SL_QDB); p3 = SL(SL_KIB); p4 = SL(SL_V); p5 = SL(SL_X5); }
      if (DBG_STOP == 3) { p0 = SL(SL_QDF); p1 = SL(SL_QDB); }
      if (DBG_STOP == 4) { p0 = SL(SL_QDF); }
      if (DBG_STOP == 5) { p0 = SL(SL_KIF); p1 = SL(SL_KIB); p2 = SL(SL_V); p3 = SL(SL_QDB); }
      if (DBG_STOP == 6) { p0 = SL(SL_X5); }
      if (DBG_STOP == 30) { float* tmp = (float*)(w + WS_SLOTS); hipLaunchKernelGGL(dbg_hsum, dim3(LROWS * DM / 256), dim3(256), 0, stream, (const bf16_t*)d_out, (const bf16_t*)d_out + (size_t)LROWS * DM, tmp); hipLaunchKernelGGL(dbg_copy, dim3(LROWS * DM / 256), dim3(256), 0, stream, tmp, (float*)d_out); }
      else hipLaunchKernelGGL(dbg_dump, dim3(LROWS * DM / 256), dim3(256), 0, stream, p0, p1, p2, p3, p4, p5, (float*)d_out); }
#endif
#endif
}
```

```cpp
#include <hip/hip_runtime.h>
#include <hip/hip_cooperative_groups.h>
#include <cstdio>
#include <cstdint>
namespace pg8 {
#define PG8_LAS __attribute__((address_space(3)))
typedef unsigned short bf16_t;
typedef short bf16x8 __attribute__((ext_vector_type(8)));
typedef float f32x4 __attribute__((ext_vector_type(4)));
typedef unsigned u32x4 __attribute__((ext_vector_type(4)));
constexpr int BM = 256, BK = 64, HALF = 128, HTB = HALF * BK * 2  , STAGE_BYTES = 8 * HTB, NXCD = 8, WGM = 8;

__host__ __device__ __forceinline__ int lds_byte(int r, int c) { const int st = (r >> 4) * 2 + (c >> 5), rr = r & 15, cc = c & 31, ob = rr * 64 + cc * 2; return st * 1024 + (ob ^ (((ob >> 9) & 1) << 5)); }
__host__ __device__ __forceinline__ void stage_rc(int b, int& R, int& C) { const int st = b / 1024, sb = b % 1024, swz = sb ^ (((sb >> 9) & 1) << 5); R = (st >> 1) * 16 + swz / 64; C = (st & 1) * 32 + (swz % 64) / 2; }
__host__ __device__ __forceinline__ int perm32(int rho) { const int n = rho >> 4, i = rho & 15; return 8 * (i >> 2) + 4 * n + (i & 3); }

struct Unit { int pm, pn; };
struct Gemm { const bf16_t* A; const bf16_t* Bt; int M, N, K; };

struct StaticOrder {
    int nM, nN, nwg, G, c;
    __host__ __device__ void init(int M, int N, int G_, int c_) { nM = M / BM; nN = N / BM; nwg = nM * nN; G = G_; c = c_; }
    __host__ __device__ bool next(int i, Unit& u) const {
        const long L = (long)i * G + c; if (L >= nwg) return false;
        int wgid = (int)L; { const int q = nwg / NXCD, r = nwg % NXCD, xcd = wgid % NXCD, off = wgid / NXCD; wgid = (xcd < r ? xcd * (q + 1) : r * (q + 1) + (xcd - r) * q) + off; }
        const int nig = WGM * nN, gid = wgid / nig, fm = gid * WGM, gsz = (nM - fm) < WGM ? (nM - fm) : WGM;
        u.pm = fm + ((wgid % nig) % gsz); u.pn = (wgid % nig) / gsz; return true;
    }
    __device__ __forceinline__ void a_ready(const Unit&) const {}
    __device__ __forceinline__ void done(const Unit&) const {}
};

__device__ __forceinline__ unsigned cvt_pk_bf16(float lo, float hi) { unsigned r; asm volatile("v_cvt_pk_bf16_f32 %0, %1, %2" : "=v"(r) : "v"(lo), "v"(hi)); return r; }
template <class Epi, class Sched, bool ALIGN_EPI = false, bool SP2 = false>
__device__ __forceinline__ void gemm_phase(PG8_LAS unsigned char* lds, const Gemm g, const Sched& S, const Epi& E) {
    const int tid = threadIdx.x, wid = __builtin_amdgcn_readfirstlane(tid >> 6), lane = tid & 63, wr = wid >> 2, wc = wid & 3, fr = lane & 15, fq = lane >> 4;
    const int K = g.K, nt = K / BK;
    unsigned voffA[2], voffB[2];
#pragma unroll
    for (int i = 0; i < 2; ++i) { int R, C; stage_rc(tid * 16 + i * 8192, R, C); const int Rb = Epi::PERM ? ((R & ~31) + perm32(R & 31)) : R;
        voffA[i] = (unsigned)(R * K + C) * 2u; voffB[i] = (unsigned)(Rb * K + C) * 2u; }
    const size_t kstep = (size_t)(BK * 2);
    const size_t hstep = (size_t)HALF * K * 2;
    const size_t tstep = 2 * hstep;
    const unsigned ldsw = (unsigned)wid * 1024u;
    const int aoff = lds_byte(wr * 64 + fr, fq * 8), boff = lds_byte(wc * 32 + fr, fq * 8);
#define PG8_SA(b, h) (((b) * 2 + (h)) * HTB)
#define PG8_SB(b, h) ((4 + (b) * 2 + (h)) * HTB)
#define PG8_STAGE(bufoff, gbase, voff) do { _Pragma("unroll") for (int _i = 0; _i < 2; ++_i) \
        __builtin_amdgcn_global_load_lds((const unsigned*)((const char*)(gbase) + (voff)[_i]), (PG8_LAS unsigned*)(lds + (bufoff) + ldsw + _i * 8192), 16, 0, 0); } while (0)
#define PG8_LDA(dst, b, h) do { _Pragma("unroll") for (int m = 0; m < 4; ++m) _Pragma("unroll") for (int k = 0; k < 2; ++k) dst[m][k] = *(const PG8_LAS bf16x8*)(lds + PG8_SA(b, h) + aoff + m * 2048 + k * 1024); } while (0)
#define PG8_LDB(dst, b, h) do { _Pragma("unroll") for (int n = 0; n < 2; ++n) _Pragma("unroll") for (int k = 0; k < 2; ++k) dst[n][k] = *(const PG8_LAS bf16x8*)(lds + PG8_SB(b, h) + boff + n * 2048 + k * 1024); } while (0)
#define PG8_MMA(ai, bj, At, Bt) do { __builtin_amdgcn_s_setprio(1); _Pragma("unroll") for (int m = 0; m < 4; ++m) _Pragma("unroll") for (int n = 0; n < 2; ++n) _Pragma("unroll") for (int k = 0; k < 2; ++k) \
        acc[ai][bj][m][n] = __builtin_amdgcn_mfma_f32_16x16x32_bf16(Bt[n][k], At[m][k], acc[ai][bj][m][n], 0, 0, 0); __builtin_amdgcn_s_setprio(0); } while (0)
#define PG8_WAIT_V(n) asm volatile("s_waitcnt vmcnt(" #n ")" ::: "memory")
#define PG8_WAIT_L(n) asm volatile("s_waitcnt lgkmcnt(" #n ")" ::: "memory")
#define PG8_BAR __builtin_amdgcn_s_barrier()
#define PG8_SCHED __builtin_amdgcn_sched_barrier(0)
    Unit cur, nxt; int ui = 0;
    if (!S.next(0, cur)) return;
    f32x4 acc[2][2][4][2];
#pragma unroll
    for (int a = 0; a < 2; ++a)
#pragma unroll
        for (int b = 0; b < 2; ++b)
#pragma unroll
            for (int m = 0; m < 4; ++m)
#pragma unroll
                for (int n = 0; n < 2; ++n) acc[a][b][m][n] = (f32x4){0.f, 0.f, 0.f, 0.f};
    bf16x8 At[4][2], B0[2][2], B1[2][2];
    const char* cA = (const char*)g.A + (size_t)cur.pm * tstep; const char* cB = (const char*)g.Bt + (size_t)cur.pn * tstep;
    S.a_ready(cur);
    if constexpr (SP2) {
        PG8_STAGE(PG8_SB(0, 0), cB, voffB); PG8_STAGE(PG8_SB(0, 1), cB + hstep, voffB); PG8_STAGE(PG8_SA(0, 0), cA, voffA); PG8_STAGE(PG8_SA(0, 1), cA + hstep, voffA);
        if (wr == 1) PG8_BAR;
        PG8_WAIT_V(2); PG8_BAR;
        PG8_STAGE(PG8_SB(1, 0), cB + kstep, voffB); PG8_STAGE(PG8_SA(1, 0), cA + kstep, voffA); PG8_STAGE(PG8_SB(1, 1), cB + hstep + kstep, voffB);
        PG8_WAIT_V(6); PG8_BAR;
    } else {
        PG8_STAGE(PG8_SB(0, 0), cB, voffB); PG8_STAGE(PG8_SA(0, 0), cA, voffA); PG8_STAGE(PG8_SB(0, 1), cB + hstep, voffB); PG8_STAGE(PG8_SA(0, 1), cA + hstep, voffA);
        if (wr == 1) PG8_BAR;
        PG8_WAIT_V(4); PG8_BAR;
        PG8_STAGE(PG8_SB(1, 0), cB + kstep, voffB); PG8_STAGE(PG8_SA(1, 0), cA + kstep, voffA); PG8_STAGE(PG8_SB(1, 1), cB + hstep + kstep, voffB);
        PG8_WAIT_V(6); PG8_BAR;
    }
    for (;;) {
        const bool has_next = S.next(ui + 1, nxt);
        const char* nA = has_next ? (const char*)g.A + (size_t)nxt.pm * tstep : cA; const char* nB = has_next ? (const char*)g.Bt + (size_t)nxt.pn * tstep : cB;
        for (int t = 0; t < nt; t += 2) {
            const bool last = (t == nt - 2);
            const char* a1 = cA + (size_t)(t + 1) * kstep;
            const char* a2 = last ? nA : cA + (size_t)(t + 2) * kstep; const char* b2 = last ? nB : cB + (size_t)(t + 2) * kstep;
            const char* a3 = a2 + kstep; const char* b3 = b2 + kstep;
            if (last && has_next) S.a_ready(nxt);
            if constexpr (SP2) {
            PG8_LDB(B0, 0, 0); PG8_LDB(B1, 0, 1); PG8_SCHED; PG8_LDA(At, 0, 0); PG8_STAGE(PG8_SA(1, 1), a1 + hstep, voffA);
            PG8_WAIT_V(8); PG8_WAIT_L(0); PG8_BAR; PG8_MMA(0, 0, At, B0); PG8_MMA(0, 1, At, B1); PG8_BAR; PG8_SCHED;
            PG8_LDA(At, 0, 1); PG8_STAGE(PG8_SB(0, 0), b2, voffB); PG8_STAGE(PG8_SB(0, 1), b2 + hstep, voffB); PG8_STAGE(PG8_SA(0, 0), a2, voffA);
            PG8_WAIT_V(8); PG8_WAIT_L(0); PG8_BAR; PG8_MMA(1, 0, At, B0); PG8_MMA(1, 1, At, B1); PG8_BAR; PG8_SCHED;
            PG8_LDB(B0, 1, 0); PG8_LDB(B1, 1, 1); PG8_SCHED; PG8_LDA(At, 1, 0); PG8_STAGE(PG8_SA(0, 1), a2 + hstep, voffA);
            PG8_WAIT_V(8); PG8_WAIT_L(0); PG8_BAR; PG8_MMA(0, 0, At, B0); PG8_MMA(0, 1, At, B1); PG8_BAR; PG8_SCHED;
            PG8_LDA(At, 1, 1); PG8_STAGE(PG8_SB(1, 0), b3, voffB); PG8_STAGE(PG8_SB(1, 1), b3 + hstep, voffB); PG8_STAGE(PG8_SA(1, 0), a3, voffA);
            PG8_WAIT_V(8); PG8_WAIT_L(0); PG8_BAR; PG8_MMA(1, 0, At, B0); PG8_MMA(1, 1, At, B1); PG8_BAR; PG8_SCHED;
            } else {
            PG8_LDB(B0, 0, 0); PG8_SCHED; PG8_LDA(At, 0, 0); PG8_STAGE(PG8_SA(1, 1), a1 + hstep, voffA);
            PG8_WAIT_L(8); PG8_BAR; PG8_WAIT_L(0); PG8_MMA(0, 0, At, B0); PG8_BAR; PG8_SCHED;
            PG8_LDB(B1, 0, 1); PG8_STAGE(PG8_SB(0, 0), b2, voffB);
            PG8_BAR; PG8_WAIT_L(0); PG8_MMA(0, 1, At, B1); PG8_BAR;
            PG8_LDA(At, 0, 1); PG8_STAGE(PG8_SA(0, 0), a2, voffA);
            PG8_BAR; PG8_WAIT_L(0); PG8_MMA(1, 0, At, B0); PG8_BAR; PG8_SCHED;
            PG8_STAGE(PG8_SB(0, 1), b2 + hstep, voffB);
            PG8_WAIT_V(6); PG8_BAR; PG8_MMA(1, 1, At, B1); PG8_BAR;
            PG8_LDB(B0, 1, 0); PG8_SCHED; PG8_LDA(At, 1, 0); PG8_STAGE(PG8_SA(0, 1), a2 + hstep, voffA);
            PG8_WAIT_L(8); PG8_BAR; PG8_WAIT_L(0); PG8_MMA(0, 0, At, B0); PG8_BAR; PG8_SCHED;
            PG8_LDB(B1, 1, 1); PG8_STAGE(PG8_SB(1, 0), b3, voffB);
            PG8_BAR; PG8_WAIT_L(0); PG8_MMA(0, 1, At, B1); PG8_BAR;
            PG8_LDA(At, 1, 1); PG8_STAGE(PG8_SA(1, 0), a3, voffA);
            PG8_BAR; PG8_WAIT_L(0); PG8_MMA(1, 0, At, B0); PG8_BAR; PG8_SCHED;
            PG8_STAGE(PG8_SB(1, 1), b3 + hstep, voffB);
            PG8_WAIT_V(6); PG8_BAR; PG8_MMA(1, 1, At, B1); PG8_BAR;
            }
        }
        if constexpr (ALIGN_EPI) { if (wr == 0) PG8_BAR; }
        if constexpr (!Epi::AFTER_DRAIN) { E(acc, cur, wr, wc, fr, fq); S.done(cur); }
        if (!has_next) break;
#pragma unroll
        for (int a = 0; a < 2; ++a)
#pragma unroll
            for (int b = 0; b < 2; ++b)
#pragma unroll
                for (int m = 0; m < 4; ++m)
#pragma unroll
                    for (int n = 0; n < 2; ++n) acc[a][b][m][n] = (f32x4){0.f, 0.f, 0.f, 0.f};
        cur = nxt; cA = nA; cB = nB; ++ui;
        if constexpr (ALIGN_EPI) { if (wr == 1) PG8_BAR; }
    }
    PG8_WAIT_V(0);
    if constexpr (!ALIGN_EPI) { if (wr == 0) PG8_BAR; }
    PG8_BAR;
    if constexpr (Epi::AFTER_DRAIN) { E.fused(acc, cur, wr, wc, fr, fq, lds, wid, lane); S.done(cur); }
#undef PG8_SA
#undef PG8_SB
#undef PG8_STAGE
#undef PG8_LDA
#undef PG8_LDB
#undef PG8_MMA
#undef PG8_WAIT_V
#undef PG8_WAIT_L
#undef PG8_BAR
#undef PG8_SCHED
}
}

#define GAS __attribute__((address_space(1)))
#define LAS __attribute__((address_space(3)))
typedef unsigned short bf16_t;
typedef short bf16x8 __attribute__((ext_vector_type(8)));
typedef short s16x4 __attribute__((ext_vector_type(4)));
typedef float f32x4 __attribute__((ext_vector_type(4)));
typedef float f32x16 __attribute__((ext_vector_type(16)));
typedef unsigned u32x4 __attribute__((ext_vector_type(4)));
typedef unsigned u32x2 __attribute__((ext_vector_type(2)));

constexpr int DM = 1024, NB = 4, TL = 8192, TC = 256;
constexpr int LROWS = NB * TL, CROWS = NB * TC, ROWS = LROWS + CROWS;
constexpr int NWAVES = 8, NTHR = 512;
constexpr size_t MiB = 1u << 20;
constexpr size_t SLOT = (size_t)ROWS * DM * 2;
constexpr size_t WS_CTL = 0, CTL_ZERO_BYTES = 1 * MiB;
constexpr size_t WS_WIN = 1 * MiB;
constexpr size_t WS_WPA = 19 * MiB, WS_WPB = 21 * MiB, WS_WOUT = 23 * MiB;
constexpr size_t WS_WG = 25 * MiB;
constexpr size_t WS_MODP = 26 * MiB;
constexpr size_t WS_GT = 27 * MiB;
constexpr size_t WS_DDF = 28 * MiB, WS_DDB = 31 * MiB;
constexpr size_t WS_SLOTS = 34 * MiB;
constexpr size_t WS_END = WS_SLOTS + 7 * SLOT;
static_assert(WS_END <= 512 * MiB, "workspace map");
enum { SL_U = 0, SL_QDF = 1, SL_KIF = 2, SL_QDB = 3, SL_KIB = 4, SL_V = 5, SL_X5 = 6 };
constexpr int CW_BAR = 4096;
constexpr int LDS_BYTES = 147456;
constexpr int MISC_OFF = 139264 + 1024;
static_assert(MISC_OFF + 128 <= LDS_BYTES, "lds map");

__device__ __forceinline__ float bf2f(unsigned short v) { return __uint_as_float((unsigned)v << 16); }
__device__ __forceinline__ float bflo(unsigned u) { return __uint_as_float(u << 16); }
__device__ __forceinline__ float bfhi(unsigned u) { return __uint_as_float(u & 0xffff0000u); }
typedef float f32x2_t __attribute__((ext_vector_type(2))); typedef __bf16 bf16x2_t __attribute__((ext_vector_type(2)));
__device__ __forceinline__ unsigned pk2(float lo, float hi) { const f32x2_t v = {lo, hi}; const bf16x2_t b = __builtin_convertvector(v, bf16x2_t); return __builtin_bit_cast(unsigned, b); }
__device__ __forceinline__ float fexp(float x) { return __builtin_amdgcn_exp2f(x * 1.4426950408889634f); }
__device__ __forceinline__ float flog(float x) { return __builtin_amdgcn_logf(x) * 0.6931471805599453f; }
__device__ __forceinline__ float fsig(float x) { return __builtin_amdgcn_rcpf(1.f + fexp(-x)); }
__device__ __forceinline__ float fsilu(float x) { return x * __builtin_amdgcn_rcpf(1.f + fexp(-x)); }

__device__ __forceinline__ int perm8(int ch) {
    const int tile = ch >> 8, cc = ch & 255, bj = cc >> 7, wc = (cc >> 5) & 3, fq = (cc >> 3) & 3, nn = (cc >> 2) & 1, e = cc & 3;
    return 256 * tile + 128 * bj + 32 * wc + 16 * nn + 4 * fq + e;
}
__device__ __forceinline__ int map_win(int n) {
    const int grp = n >> 10, ch = n & 1023;
    if (grp <= 3) {
        const int h = ch >> 7, half = (ch >> 6) & 1, cc = ch & 63, wc = cc >> 4, fq = (cc >> 2) & 3, e = cc & 3, bj = grp >> 1, nn = grp & 1;
        return 256 * (2 * h + half) + 128 * bj + 32 * wc + 16 * nn + 4 * fq + e;
    }
    if (grp == 5) return 4096 + perm8(ch);
    if (grp == 4) return 5120 + perm8(ch);
    return 6144 + 1024 * (grp - 6) + perm8(ch);
}
template <int MAP>
__device__ __forceinline__ int map_row(int n) { return MAP == 1 ? map_win(n) : (MAP == 2 ? perm8(n) : n); }
template <int MAP>
__device__ __forceinline__ void transpose_item(const float* W, int K, int N, bf16_t* WT, LAS float* scr, int item, int lane) {
    const int nblk = N / 32, kb = item / nblk, nb = item % nblk, k0 = 64 * kb, n0 = 32 * nb;
#pragma unroll 8
    for (int i = 0; i < 32; ++i) { const int kk = 2 * i + (lane >> 5); scr[kk * 33 + (lane & 31)] = W[(size_t)(k0 + kk) * N + n0 + (lane & 31)]; }
    asm volatile("s_waitcnt lgkmcnt(0)" ::: "memory");
    const int c = lane & 7;
#pragma unroll
    for (int j = 0; j < 4; ++j) { const int n = (lane >> 3) + 8 * j; const LAS float* s = scr + (8 * c) * 33 + n;
        u32x4 o; o.x = pk2(s[0 * 33], s[1 * 33]); o.y = pk2(s[2 * 33], s[3 * 33]); o.z = pk2(s[4 * 33], s[5 * 33]); o.w = pk2(s[6 * 33], s[7 * 33]);
        *(u32x4*)(WT + (size_t)map_row<MAP>(n0 + n) * K + k0 + 8 * c) = o; }
    asm volatile("s_waitcnt lgkmcnt(0)" ::: "memory");
}
__device__ __forceinline__ void modp_item(const float* c, const float* c_ctx, const float* w_mod, float* modp, int item, int lane) {
    const int kc = item / 12, cb = item % 12, col = cb * 256 + lane * 4;
    f32x4 acc[5];
#pragma unroll
    for (int r = 0; r < 5; ++r) acc[r] = (f32x4){0.f, 0.f, 0.f, 0.f};
#pragma unroll 8
    for (int kk = 0; kk < 64; ++kk) {
        const int k = kc * 64 + kk;
        const f32x4 wv = *(const f32x4*)(w_mod + (size_t)k * 3072 + col);
#pragma unroll
        for (int r = 0; r < 5; ++r) { const float sv = r < 4 ? c[r * DM + k] : c_ctx[k]; acc[r] += wv * (sv / (1.f + __expf(-sv))); }
    }
#pragma unroll
    for (int r = 0; r < 5; ++r) *(f32x4*)(modp + (size_t)(kc * 5 + r) * 3072 + col) = acc[r];
}

__device__ __forceinline__ void urow(const float* xrow, bf16_t* orow, const LAS float* tab, int lane) {
    const GAS f32x4* xr = (const GAS f32x4*)xrow + lane;
    GAS u32x2* o8 = (GAS u32x2*)orow + lane;
#pragma unroll
    for (int j = 0; j < 4; ++j) {
        const f32x4 v = xr[64 * j];
        const f32x4 sh = *(const LAS f32x4*)(tab + 4 * lane + 256 * j), sc = *(const LAS f32x4*)(tab + 1024 + 4 * lane + 256 * j);
        u32x2 w; w.x = pk2(v.x * sc.x + sh.x, v.y * sc.y + sh.y); w.y = pk2(v.z * sc.z + sh.z, v.w * sc.w + sh.w);
        o8[64 * j] = w;
    }
}

namespace epi {
using pg8::Unit; using pg8::BM; using pg8::HALF;
__device__ __forceinline__ int lane_now() { int l; asm volatile("v_mbcnt_lo_u32_b32 %0, -1, 0\n\tv_mbcnt_hi_u32_b32 %0, -1, %0" : "=v"(l)); return l; }
template <int CTRL> __device__ __forceinline__ float dpp0(float x) { return __int_as_float(__builtin_amdgcn_update_dpp(0, __float_as_int(x), CTRL, 0xF, 0xF, true)); }
__device__ __forceinline__ float rowscan16(float x) {
    x += dpp0<0x111>(x); x += dpp0<0x112>(x); x += dpp0<0x114>(x); x += dpp0<0x118>(x); return x;
}
__device__ __forceinline__ float rowsum16(float x) {
    x += dpp0<0x128>(x); x += dpp0<0x124>(x); x += dpp0<0x122>(x); x += dpp0<0x121>(x); return x;
}
struct EpiMix {
    static constexpr bool PERM = false, AFTER_DRAIN = false;
    bf16_t *QDf, *KIf, *QDb, *KIb, *V, *X5; float *Ddf, *Ddb; const float* b_in; const float* lbl;
    __device__ __forceinline__ void operator()(const f32x4 (&acc)[2][2][4][2], const Unit& u, int wr, int wc, int fr_, int fq_) const {
        const int ln_ = lane_now(), fr = ln_ & 15, fq = ln_ >> 4;
        const int row0 = u.pm * BM + wr * 64 + fr;
        if (u.pn >= 16) {
            const int chb = (u.pn - 16) * 256 + wc * 32 + 8 * fq;
            f32x4 bv[2][2];
#pragma unroll
            for (int bj = 0; bj < 2; ++bj)
#pragma unroll
                for (int n = 0; n < 2; ++n) bv[bj][n] = *(const f32x4*)(b_in + 5120 + chb + bj * HALF + 4 * n);
#pragma unroll
            for (int ai = 0; ai < 2; ++ai)
#pragma unroll
                for (int m = 0; m < 4; ++m) { bf16_t* rowp = X5 + (size_t)(row0 + ai * HALF + m * 16) * DM + chb;
#pragma unroll
                    for (int bj = 0; bj < 2; ++bj) { const f32x4 v0 = acc[ai][bj][m][0] + bv[bj][0], v1 = acc[ai][bj][m][1] + bv[bj][1];
                        u32x4 w; w.x = pk2(v0[0], v0[1]); w.y = pk2(v0[2], v0[3]); w.z = pk2(v1[0], v1[1]); w.w = pk2(v1[2], v1[3]);
                        *(u32x4*)(rowp + bj * HALF) = w; } }
            return;
        }
        const int ch0 = (u.pn >> 1) * 128 + (u.pn & 1) * 64 + wc * 16 + fq * 4;
        const f32x4 bq = *(const f32x4*)(b_in + ch0), bff = *(const f32x4*)(b_in + 1024 + ch0), bfb = *(const f32x4*)(b_in + 2048 + ch0), bvv = *(const f32x4*)(b_in + 3072 + ch0);
        f32x4 lbf, lbb;
        { const f32x4 a0 = *(const f32x4*)(lbl + ch0), a1 = *(const f32x4*)(lbl + 2048 + ch0), c0 = *(const f32x4*)(lbl + 1024 + ch0), c1 = *(const f32x4*)(lbl + 3072 + ch0);
#pragma unroll
          for (int e = 0; e < 4; ++e) { lbf[e] = __builtin_amdgcn_rcpf(1.f + fexp(a1[e] - a0[e])); lbb[e] = __builtin_amdgcn_rcpf(1.f + fexp(c1[e] - c0[e])); } }
#pragma unroll
        for (int ai = 0; ai < 2; ++ai) {
            const int chunk = (u.pm * BM + ai * HALF + wr * 64) >> 6;
#pragma unroll
            for (int ep = 0; ep < 2; ++ep) {
                float q[2][4], lf[2][4], lb_[2][4], kf[2][4], kb[2][4], totb[2];
#pragma unroll
                for (int e2 = 0; e2 < 2; ++e2) {
                    const int e = 2 * ep + e2;
                    float tf = 0.f, tb = 0.f;
#pragma unroll
                    for (int m = 0; m < 4; ++m) {
                        const float zq = acc[ai][0][m][0][e] + bq[e], zf = acc[ai][0][m][1][e] + bff[e], zb = acc[ai][1][m][0][e] + bfb[e];
                        q[e2][m] = fsilu(zq) * 0.08838834764831845f;
                        const float ef = fexp(-zf), sf = __builtin_amdgcn_rcpf(1.f + ef);
                        const float eb = fexp(-zb), sb = __builtin_amdgcn_rcpf(1.f + eb);
                        lf[e2][m] = flog(lbf[e] + (1.f - lbf[e]) * sf); kf[e2][m] = (1.f - lbf[e]) * (ef * sf);
                        lb_[e2][m] = flog(lbb[e] + (1.f - lbb[e]) * sb); kb[e2][m] = (1.f - lbb[e]) * (eb * sb);
                        tf += lf[e2][m]; tb += lb_[e2][m];
                    }
                    tf = rowsum16(tf); tb = rowsum16(tb); totb[e2] = tb;
                    if (fr == 0) { const unsigned od = ((unsigned)chunk * DM + ch0 + e) * 4u; *(float*)((unsigned char*)Ddf + od) = fexp(tf); *(float*)((unsigned char*)Ddb + od) = fexp(tb); }
                }
                __builtin_amdgcn_sched_barrier(0);
                float cf[2] = {0.f, 0.f}, cb[2] = {0.f, 0.f};
#pragma unroll
                for (int m = 0; m < 4; ++m) {
                    float oqf[2], okf[2], oqb[2], okb[2];
#pragma unroll
                    for (int e2 = 0; e2 < 2; ++e2) {
                        const float gf = rowscan16(lf[e2][m]) + cf[e2];
                        const float pbv = rowscan16(lb_[e2][m]) + cb[e2];
                        const float gb = totb[e2] - pbv + lb_[e2][m];
                        cf[e2] += rowsum16(lf[e2][m]); cb[e2] += rowsum16(lb_[e2][m]);
                        const float egf = fexp(gf), egb = fexp(gb);
                        oqf[e2] = q[e2][m] * egf; okf[e2] = kf[e2][m] * __builtin_amdgcn_rcpf(egf);
                        oqb[e2] = q[e2][m] * egb; okb[e2] = kb[e2][m] * __builtin_amdgcn_rcpf(egb);
                    }
                    const unsigned o = ((unsigned)(row0 + ai * HALF + m * 16) * DM + ch0 + 2 * ep) * 2u;
                    *(unsigned*)((unsigned char*)QDf + o) = pk2(oqf[0], oqf[1]); *(unsigned*)((unsigned char*)KIf + o) = pk2(okf[0], okf[1]);
                    *(unsigned*)((unsigned char*)QDb + o) = pk2(oqb[0], oqb[1]); *(unsigned*)((unsigned char*)KIb + o) = pk2(okb[0], okb[1]);
                    __builtin_amdgcn_sched_barrier(0);
                }
            }
#pragma unroll
            for (int m = 0; m < 4; ++m) {
                const unsigned o = ((unsigned)(row0 + ai * HALF + m * 16) * DM + ch0) * 2u;
                const f32x4 vv = acc[ai][1][m][1] + bvv;
                *(u32x2*)((unsigned char*)V + o) = (u32x2){pk2(vv[0], vv[1]), pk2(vv[2], vv[3])};
            }
        }
    }
};
struct EpiGate {
    static constexpr bool PERM = false, AFTER_DRAIN = false;
    bf16_t *A1, *A2, *S7, *S8; const bf16_t *ON, *HF, *HB; const float* b_in;
    __device__ __forceinline__ void operator()(const f32x4 (&acc)[2][2][4][2], const Unit& u, int wr, int wc, int fr_, int fq_) const {
        const int ln_ = lane_now(), fr = ln_ & 15, fq = ln_ >> 4;
        const int grp = u.pn >> 2, row0 = u.pm * BM + wr * 64 + fr, chb = (u.pn & 3) * 256 + wc * 32 + 8 * fq;
        const int boff = (grp == 0 ? 4096 : grp == 1 ? 6144 : grp == 2 ? 7168 : 8192) + chb;
        bf16_t* O = grp == 0 ? A1 : grp == 1 ? A2 : grp == 2 ? S7 : S8;
        f32x4 bv[2][2];
#pragma unroll
        for (int bj = 0; bj < 2; ++bj)
#pragma unroll
            for (int n = 0; n < 2; ++n) bv[bj][n] = *(const f32x4*)(b_in + boff + bj * HALF + 4 * n);
#pragma unroll
        for (int ai = 0; ai < 2; ++ai)
#pragma unroll
            for (int m = 0; m < 4; ++m) { const size_t ro = (size_t)(row0 + ai * HALF + m * 16) * DM + chb;
#pragma unroll
                for (int bj = 0; bj < 2; ++bj) { const f32x4 v0 = acc[ai][bj][m][0] + bv[bj][0], v1 = acc[ai][bj][m][1] + bv[bj][1];
                    float r[8];
                    if (grp >= 2) {
#pragma unroll
                        for (int j = 0; j < 4; ++j) { r[j] = fsig(v0[j]); r[4 + j] = fsig(v1[j]); }
                    } else {
                        float a[8];
                        if (grp == 0) { const u32x4 x = *(const u32x4*)(ON + ro + bj * HALF);
                            a[0] = bflo(x.x); a[1] = bfhi(x.x); a[2] = bflo(x.y); a[3] = bfhi(x.y); a[4] = bflo(x.z); a[5] = bfhi(x.z); a[6] = bflo(x.w); a[7] = bfhi(x.w);
                        } else { const u32x4 x = *(const u32x4*)(HF + ro + bj * HALF), y = *(const u32x4*)(HB + ro + bj * HALF);
                            a[0] = bflo(x.x) + bflo(y.x); a[1] = bfhi(x.x) + bfhi(y.x); a[2] = bflo(x.y) + bflo(y.y); a[3] = bfhi(x.y) + bfhi(y.y);
                            a[4] = bflo(x.z) + bflo(y.z); a[5] = bfhi(x.z) + bfhi(y.z); a[6] = bflo(x.w) + bflo(y.w); a[7] = bfhi(x.w) + bfhi(y.w); }
#pragma unroll
                        for (int j = 0; j < 4; ++j) { r[j] = a[j] * fsilu(v0[j]); r[4 + j] = a[4 + j] * fsilu(v1[j]); }
                    }
                    u32x4 w; w.x = pk2(r[0], r[1]); w.y = pk2(r[2], r[3]); w.z = pk2(r[4], r[5]); w.w = pk2(r[6], r[7]);
                    *(u32x4*)(O + ro + bj * HALF) = w; } }
    }
};
template <int MODE> struct EpiY {
    static constexpr bool PERM = false, AFTER_DRAIN = false;
    bf16_t* O; const bf16_t* S; const bf16_t* YA;
    __device__ __forceinline__ void operator()(const f32x4 (&acc)[2][2][4][2], const Unit& u, int wr, int wc, int fr_, int fq_) const {
        const int ln_ = lane_now(), fr = ln_ & 15, fq = ln_ >> 4;
        const int row0 = u.pm * BM + wr * 64 + fr, chb = u.pn * 256 + wc * 32 + 8 * fq;
#pragma unroll
        for (int ai = 0; ai < 2; ++ai)
#pragma unroll
            for (int m = 0; m < 4; ++m) { const size_t ro = (size_t)(row0 + ai * HALF + m * 16) * DM + chb;
#pragma unroll
                for (int bj = 0; bj < 2; ++bj) { const f32x4 v0 = acc[ai][bj][m][0], v1 = acc[ai][bj][m][1];
                    const u32x4 s = *(const u32x4*)(S + ro + bj * HALF);
                    float r[8] = {bflo(s.x) * v0[0], bfhi(s.x) * v0[1], bflo(s.y) * v0[2], bfhi(s.y) * v0[3], bflo(s.z) * v1[0], bfhi(s.z) * v1[1], bflo(s.w) * v1[2], bfhi(s.w) * v1[3]};
                    if (MODE == 1) { const u32x4 y = *(const u32x4*)(YA + ro + bj * HALF);
                        r[0] += bflo(y.x); r[1] += bfhi(y.x); r[2] += bflo(y.y); r[3] += bfhi(y.y); r[4] += bflo(y.z); r[5] += bfhi(y.z); r[6] += bflo(y.w); r[7] += bfhi(y.w); }
                    u32x4 w; w.x = pk2(r[0], r[1]); w.y = pk2(r[2], r[3]); w.z = pk2(r[4], r[5]); w.w = pk2(r[6], r[7]);
                    *(u32x4*)(O + ro + bj * HALF) = w; } }
    }
};
struct EpiPre {
    static constexpr bool PERM = false, AFTER_DRAIN = false;
    const float* x; float* out; const float* gt;
    __device__ __forceinline__ void operator()(const f32x4 (&acc)[2][2][4][2], const Unit& u, int wr, int wc, int fr_, int fq_) const {
        const int ln_ = lane_now(), fr = ln_ & 15, fq = ln_ >> 4;
        const int row0 = u.pm * BM + wr * 64 + fr, col0 = u.pn * BM + wc * 32 + 4 * fq, b = (u.pm * BM) >> 13;
        f32x4 gv[2][2];
#pragma unroll
        for (int bj = 0; bj < 2; ++bj)
#pragma unroll
            for (int n = 0; n < 2; ++n) gv[bj][n] = *(const f32x4*)(gt + b * DM + col0 + bj * HALF + n * 16);
#pragma unroll
        for (int ai = 0; ai < 2; ++ai)
#pragma unroll
            for (int m = 0; m < 4; ++m) { const size_t ro = (size_t)(row0 + ai * HALF + m * 16) * DM + col0;
#pragma unroll
                for (int bj = 0; bj < 2; ++bj)
#pragma unroll
                    for (int n = 0; n < 2; ++n) { const f32x4 xv = *(const f32x4*)(x + ro + bj * HALF + n * 16);
                        *(f32x4*)(out + ro + bj * HALF + n * 16) = xv * 1.189207115f + gv[bj][n] * acc[ai][bj][m][n]; } }
    }
};
}

namespace mix {
__device__ __forceinline__ unsigned off_b(unsigned row, unsigned ch) { return 256u * row + 16u * (ch ^ (((row & 3u) << 2) | ((row >> 2) & 3u))); }
__device__ __forceinline__ unsigned off_p(unsigned row, unsigned ch) { return 128u * row + 16u * (ch ^ ((row >> 1) & 7u)); }
__device__ __forceinline__ unsigned rr16(unsigned lane, unsigned rb, unsigned s) { return off_b((lane & 15u) + 16u * rb, 4u * s + (lane >> 4)); }
__device__ __forceinline__ unsigned rr32(unsigned lane, unsigned rb, unsigned s) { return off_b(32u * rb + (lane & 31u), 2u * s + (lane >> 5)); }
__device__ __forceinline__ unsigned rr32p(unsigned lane, unsigned rb, unsigned s) { return off_p(32u * rb + (lane & 31u), 2u * s + (lane >> 5)); }
__device__ __forceinline__ unsigned tr32(unsigned lane, unsigned c, unsigned ks, unsigned t) {
    const unsigned h = lane >> 5, blk = (lane >> 4) & 1u, q = (lane & 15u) >> 2, p = lane & 3u;
    return off_b(16u * ks + 8u * h + 4u * t + q, 4u * c + 2u * blk + (p >> 1)) + 8u * (p & 1u);
}
typedef short v4i16_t __attribute__((ext_vector_type(4)));
__device__ __forceinline__ bf16x8 ld128(const LAS unsigned char* base, unsigned off) { return *(const LAS bf16x8*)(base + off); }
__device__ __forceinline__ bf16x8 ldtr(const LAS unsigned char* base, unsigned off0, unsigned off1) {
    const v4i16_t lo = __builtin_amdgcn_ds_read_tr16_b64_v4i16((LAS v4i16_t*)(base + off0)), hi = __builtin_amdgcn_ds_read_tr16_b64_v4i16((LAS v4i16_t*)(base + off1));
    return (bf16x8){lo[0], lo[1], lo[2], lo[3], hi[0], hi[1], hi[2], hi[3]};
}
#define MFMA32(a, b, c) __builtin_amdgcn_mfma_f32_32x32x16_bf16((a), (b), (c), 0, 0, 0)
#define MFMA16(a, b, c) __builtin_amdgcn_mfma_f32_16x16x32_bf16((a), (b), (c), 0, 0, 0)
#define WG_BAR() do { asm volatile("s_waitcnt vmcnt(0) lgkmcnt(0)" ::: "memory"); __builtin_amdgcn_s_barrier(); asm volatile("" ::: "memory"); } while (0)
#define WG_BAR_L() do { asm volatile("s_waitcnt lgkmcnt(0)" ::: "memory"); __builtin_amdgcn_s_barrier(); asm volatile("" ::: "memory"); } while (0)

constexpr unsigned G_TILE = 16384, G_P = 6 * G_TILE, G_ST = G_P + 8192, G_END = G_ST + 32768;
static_assert(G_END == 139264, "gla lds");
__device__ __forceinline__ void gla_wg(LAS unsigned char* lds, int b, int h, int dir, bf16_t* QD, const bf16_t* KI, const bf16_t* V, const float* Dd) {
    const unsigned tid = threadIdx.x, lane = tid & 63u, hh = lane >> 5;
    const int w = __builtin_amdgcn_readfirstlane((int)(tid >> 6));
    const int cb = w & 1, jb = w >> 1;
    const int cb16 = w >> 1, sbp = 2 * (w & 1);
    for (unsigned i = tid; i < 32768u / 16u; i += NTHR) *(LAS u32x4*)(lds + G_ST + 16u * i) = (u32x4){0u, 0u, 0u, 0u};
    f32x16 sacc[2];
#pragma unroll
    for (int i = 0; i < 2; ++i)
#pragma unroll
        for (int r = 0; r < 16; ++r) sacc[i][r] = 0.f;
    const unsigned lrow = tid >> 3, lch = 2u * (tid & 7u);
    const size_t hoff = (size_t)h * 128;
    u32x4 nq[2], nk[2], nv[2]; f32x4 ndv;
    constexpr unsigned G_D = G_END;
    auto chunk_base = [&](int n) -> int { return n < 4 ? (LROWS + b * TC + 64 * (dir ? 3 - n : n)) : (b * TL + 64 * (dir ? 127 - (n - 4) : (n - 4))); };
#define GLA_ISSUE(n) do { const int base_ = chunk_base(n); const size_t go_ = (size_t)(base_ + (dir ? 63 - (int)lrow : (int)lrow)) * DM + hoff + lch * 8; \
        nq[0] = *(const u32x4*)(QD + go_); nq[1] = *(const u32x4*)(QD + go_ + 8); nk[0] = *(const u32x4*)(KI + go_); nk[1] = *(const u32x4*)(KI + go_ + 8); \
        nv[0] = *(const u32x4*)(V + go_); nv[1] = *(const u32x4*)(V + go_ + 8); \
        if (tid < 32u) ndv = *(const f32x4*)(Dd + (size_t)(base_ >> 6) * DM + hoff + 4 * tid); } while (0)
#define GLA_WRITE(buf) do { LAS unsigned char* t_ = lds + (buf) * 3u * G_TILE; \
        *(LAS u32x4*)(t_ + off_b(lrow, lch)) = nq[0]; *(LAS u32x4*)(t_ + off_b(lrow, lch + 1)) = nq[1]; \
        *(LAS u32x4*)(t_ + G_TILE + off_b(lrow, lch)) = nk[0]; *(LAS u32x4*)(t_ + G_TILE + off_b(lrow, lch + 1)) = nk[1]; \
        *(LAS u32x4*)(t_ + 2u * G_TILE + off_b(lrow, lch)) = nv[0]; *(LAS u32x4*)(t_ + 2u * G_TILE + off_b(lrow, lch + 1)) = nv[1]; \
        if (tid < 32u) *(LAS f32x4*)(lds + G_D + (buf) * 512u + 16u * tid) = ndv; } while (0)
    GLA_ISSUE(0);
    GLA_WRITE(0);
    GLA_ISSUE(1);
    WG_BAR_L();
    const LAS unsigned char* Pm = lds + G_P; const LAS unsigned char* ST = lds + G_ST;
    for (int n = 0; n < 132; ++n) {
        const unsigned cur = (unsigned)n & 1u;
        const LAS unsigned char* qd = lds + cur * 3u * G_TILE; const LAS unsigned char* ki = qd + G_TILE; const LAS unsigned char* vv = qd + 2u * G_TILE;
        const bool latent = n >= 4;
        f32x16 oacc;
#pragma unroll
        for (int r = 0; r < 16; ++r) oacc[r] = 0.f;
        if (latent) {
            bf16x8 qf[4];
#pragma unroll
            for (int s = 0; s < 4; ++s) qf[s] = ld128(qd, rr16(lane, cb16, s));
#pragma unroll
            for (int i = 0; i < 2; ++i) {
                const int sb = sbp + i;
                f32x4 a = (f32x4){0.f, 0.f, 0.f, 0.f};
                if (sb <= cb16) {
#pragma unroll
                    for (int s = 0; s < 4; ++s) a = MFMA16(ld128(ki, rr16(lane, sb, s)), qf[s], a);
                }
                const int c = 16 * cb16 + (int)(lane & 15u), s0 = 16 * sb + 4 * (int)(lane >> 4);
                float r[4];
#pragma unroll
                for (int e = 0; e < 4; ++e) r[e] = (s0 + e <= c) ? a[e] : 0.f;
                *(LAS u32x2*)(lds + G_P + off_p((unsigned)c, (unsigned)(2 * sb) + (lane >> 5)) + 8u * ((lane >> 4) & 1u)) = (u32x2){pk2(r[0], r[1]), pk2(r[2], r[3])};
            }
#pragma unroll
            for (int s = 0; s < 8; ++s) oacc = MFMA32(ld128(ST, rr32(lane, jb, s)), ld128(qd, rr32(lane, cb, s)), oacc);
        }
        WG_BAR_L();
        bf16x8 vf[4];
#pragma unroll
        for (int ks = 0; ks < 4; ++ks) vf[ks] = ldtr(vv, tr32(lane, jb, ks, 0), tr32(lane, jb, ks, 1));
        if (latent) {
#pragma unroll
            for (int ks = 0; ks < 4; ++ks) oacc = MFMA32(vf[ks], ld128(Pm, rr32p(lane, cb, ks)), oacc);
            const int c = 32 * cb + (int)(lane & 31u);
            bf16_t* orow = QD + (size_t)(chunk_base(n) + (dir ? 63 - c : c)) * DM + hoff + 32 * jb + 4 * hh;
#pragma unroll
            for (int g = 0; g < 4; ++g) *(u32x2*)(orow + 8 * g) = (u32x2){pk2(oacc[4 * g], oacc[4 * g + 1]), pk2(oacc[4 * g + 2], oacc[4 * g + 3])};
        }
#pragma unroll
        for (int i = 0; i < 2; ++i) {
            const int chb = 2 * cb + i;
#pragma unroll
            for (int ks = 0; ks < 4; ++ks) sacc[i] = MFMA32(ldtr(ki, tr32(lane, chb, ks, 0), tr32(lane, chb, ks, 1)), vf[ks], sacc[i]);
#pragma unroll
            for (int g = 0; g < 4; ++g) {
                const f32x4 dv = *(const LAS f32x4*)(lds + G_D + cur * 512u + 4u * (unsigned)(32 * chb + 8 * g) + 16u * hh);
#pragma unroll
                for (int e = 0; e < 4; ++e) sacc[i][4 * g + e] *= dv[e];
                *(LAS u32x2*)(lds + G_ST + off_b(32u * jb + (lane & 31u), (unsigned)(4 * chb + g)) + 8u * hh) = (u32x2){pk2(sacc[i][4 * g], sacc[i][4 * g + 1]), pk2(sacc[i][4 * g + 2], sacc[i][4 * g + 3])};
            }
        }
        if (n + 1 < 132) {
            GLA_WRITE(cur ^ 1u);
            if (n + 2 < 132) GLA_ISSUE(n + 2);
        }
        WG_BAR_L();
    }
    asm volatile("s_waitcnt vmcnt(0)" ::: "memory");
#undef GLA_ISSUE
#undef GLA_WRITE
}

template <int CTRL> __device__ __forceinline__ float dppz(float x) { return __int_as_float(__builtin_amdgcn_update_dpp(0, __float_as_int(x), CTRL, 0xF, 0xF, true)); }
template <int CTRL> __device__ __forceinline__ float dpp1(float x) { return __int_as_float(__builtin_amdgcn_update_dpp(0x3f800000, __float_as_int(x), CTRL, 0xF, 0xF, false)); }
template <int DIR> __device__ __forceinline__ void rowscan_ab(float& A, float& B) {
    { const float bp = dppz<DIR ? 0x101 : 0x111>(B), ap = dpp1<DIR ? 0x101 : 0x111>(A); B = __builtin_fmaf(A, bp, B); A *= ap; }
    { const float bp = dppz<DIR ? 0x102 : 0x112>(B), ap = dpp1<DIR ? 0x102 : 0x112>(A); B = __builtin_fmaf(A, bp, B); A *= ap; }
    { const float bp = dppz<DIR ? 0x104 : 0x114>(B), ap = dpp1<DIR ? 0x104 : 0x114>(A); B = __builtin_fmaf(A, bp, B); A *= ap; }
    { const float bp = dppz<DIR ? 0x108 : 0x118>(B), ap = dpp1<DIR ? 0x108 : 0x118>(A); B = __builtin_fmaf(A, bp, B); A *= ap; }
}
template <int DIR> __device__ __forceinline__ float rowlast(float x) { return __int_as_float(__builtin_amdgcn_ds_swizzle(__float_as_int(x), DIR ? 0x0010 : 0x01F0)); }
template <int DIR>
__device__ __forceinline__ void rglru_dir(LAS unsigned char* lds, int b, int g, const bf16_t* X5, const float* conv_w, const float* conv_b, const bf16_t* Wg,
                                          const float* b_r, const float* b_i, const float* lam, bf16_t* Hout) {
    constexpr int dir = DIR;
    const unsigned tid = threadIdx.x, lane = tid & 63u, fr = lane & 15u, fq = lane >> 4;
    const int w = __builtin_amdgcn_readfirstlane((int)(tid >> 6));
    const unsigned c4 = tid & 31u, arow = tid >> 5;
    f32x4 cw[4], cbv;
    { const int chg = g * 128 + (int)c4 * 4;
#pragma unroll
      for (int k = 0; k < 4; ++k) cw[k] = *(const f32x4*)(conv_w + k * DM + chg);
      cbv = *(const f32x4*)(conv_b + chg); }
    bf16x8 wrf[4], wif[4];
    { const bf16_t* wb = Wg + (size_t)((dir * 8 + g) * 2) * 16384 + (size_t)(16 * w + (int)fr) * 128 + 8 * fq;
#pragma unroll
      for (int s = 0; s < 4; ++s) { wrf[s] = *(const bf16x8*)(wb + 32 * s); wif[s] = *(const bf16x8*)(wb + 16384 + 32 * s); } }
    const int chl = g * 128 + 16 * w + 4 * (int)fq;
    constexpr float L2E = 1.4426950408889634f;
    const f32x4 brv = *(const f32x4*)(b_r + dir * DM + chl), biv = *(const f32x4*)(b_i + dir * DM + chl);
    f32x4 c1v;
    { const f32x4 lm = *(const f32x4*)(lam + dir * DM + chl);
#pragma unroll
      for (int e = 0; e < 4; ++e) c1v[e] = -8.f * L2E * log1pf(__expf(-lm[e])); }
    f32x4 hc = (f32x4){0.f, 0.f, 0.f, 0.f};
    u32x2 ld11[11];
#define RG_SEQ(it, br_, st_, sl_, p0_, em_) int br_, st_, sl_, p0_; bool em_; \
        if ((it) < 2) { const int hf_ = dir ? 1 - (it) : (it); br_ = LROWS + b * TC; st_ = 1; sl_ = TC; p0_ = 128 * hf_; em_ = false; } \
        else { const int col_ = dir ? 63 - ((it) - 2) : ((it) - 2); br_ = b * TL + col_; st_ = 64; sl_ = 128; p0_ = 0; em_ = true; }
#define RG_ISSUE(it) do { RG_SEQ(it, br_, st_, sl_, p0_, em_) (void)em_; \
        _Pragma("unroll") for (int k_ = 0; k_ < 11; ++k_) { const int pos_ = p0_ + 8 * (int)arow + k_ - 1; \
            ld11[k_] = (pos_ >= 0 && pos_ < sl_) ? *(const u32x2*)(X5 + (size_t)(br_ + pos_ * st_) * DM + g * 128 + c4 * 4) : (u32x2){0u, 0u}; } } while (0)
#define RG_CONV(buf) do { LAS unsigned char* xi_ = lds + (buf) * 32768u; \
        _Pragma("unroll") for (int r_ = 0; r_ < 8; ++r_) { f32x4 o_ = cbv; \
            _Pragma("unroll") for (int k_ = 0; k_ < 4; ++k_) { const u32x2 x_ = ld11[r_ + k_]; \
                o_[0] += cw[k_][0] * bflo(x_.x); o_[1] += cw[k_][1] * bfhi(x_.x); o_[2] += cw[k_][2] * bflo(x_.y); o_[3] += cw[k_][3] * bfhi(x_.y); } \
            *(LAS u32x2*)(xi_ + off_b(8u * arow + (unsigned)r_, c4 >> 1) + 8u * (c4 & 1u)) = (u32x2){pk2(o_[0], o_[1]), pk2(o_[2], o_[3])}; } } while (0)
    RG_ISSUE(0);
    RG_CONV(0);
    WG_BAR_L();
    for (int it = 0; it < 66; ++it) {
        const unsigned cur = (unsigned)it & 1u;
        const LAS unsigned char* xi = lds + cur * 32768u;
        if (it + 1 < 66) RG_ISSUE(it + 1);
        RG_SEQ(it, base_row, stride, seqlen, pos0, emit) (void)seqlen;
#pragma unroll
        for (int hf = 0; hf < 2; ++hf) {
        f32x4 racc[4], iacc[4];
#pragma unroll
        for (int m4 = 0; m4 < 4; ++m4) {
            const int mb = (dir ? 1 - hf : hf) * 4 + m4;
            racc[m4] = brv; iacc[m4] = biv;
#pragma unroll
            for (int s = 0; s < 4; ++s) { const bf16x8 xf = ld128(xi, rr16(lane, (unsigned)mb, (unsigned)s)); racc[m4] = MFMA16(wrf[s], xf, racc[m4]); iacc[m4] = MFMA16(wif[s], xf, iacc[m4]); }
        }
#pragma unroll
        for (int mm = 0; mm < 4; ++mm) {
            const int m4 = dir ? 3 - mm : mm, mb = (dir ? 1 - hf : hf) * 4 + m4;
            const u32x2 xr = *(const LAS u32x2*)(xi + off_b(16u * (unsigned)mb + fr, 2u * (unsigned)w + (fq >> 1)) + 8u * (fq & 1u));
            const float xc[4] = {bflo(xr.x), bfhi(xr.x), bflo(xr.y), bfhi(xr.y)};
            f32x4 hv;
#pragma unroll
            for (int e = 0; e < 4; ++e) {
                const float rg = __builtin_amdgcn_rcpf(1.f + __builtin_amdgcn_exp2f(-L2E * racc[m4][e])), ig = __builtin_amdgcn_rcpf(1.f + __builtin_amdgcn_exp2f(-L2E * iacc[m4][e]));
                float A = __builtin_amdgcn_exp2f(rg * c1v[e]);
                float B = __builtin_amdgcn_sqrtf(fmaxf(__builtin_fmaf(-A, A, 1.f), 0.f)) * (ig * xc[e]);
                rowscan_ab<DIR>(A, B);
                const float hval = __builtin_fmaf(A, hc[e], B);
                hc[e] = __builtin_fmaf(rowlast<DIR>(A), hc[e], rowlast<DIR>(B));
                hv[e] = hval;
            }
            if (emit) {
                const int pos = pos0 + 16 * mb + (int)fr;
                *(u32x2*)(Hout + (size_t)(base_row + pos * stride) * DM + chl) = (u32x2){pk2(hv[0], hv[1]), pk2(hv[2], hv[3])};
            }
        }
        }
        if (it + 1 < 66) { RG_CONV(cur ^ 1u); }
        WG_BAR_L();
    }
    asm volatile("s_waitcnt vmcnt(0)" ::: "memory");
#undef RG_ISSUE
#undef RG_CONV
#undef RG_SEQ
}
__device__ __forceinline__ void rglru_wg(LAS unsigned char* lds, int b, int g, int dir, const bf16_t* X5, const float* conv_w, const float* conv_b, const bf16_t* Wg,
                                         const float* b_r, const float* b_i, const float* lam, bf16_t* Hout) {
    if (dir) rglru_dir<1>(lds, b, g, X5, conv_w, conv_b, Wg, b_r, b_i, lam, Hout); else rglru_dir<0>(lds, b, g, X5, conv_w, conv_b, Wg, b_r, b_i, lam, Hout);
}
}

__device__ __forceinline__ void norm_row(bf16_t* Of, const bf16_t* Ob, const float* gn, int lane) {
    const u32x4 a0 = *(const u32x4*)(Of + 16 * lane), a1 = *(const u32x4*)(Of + 16 * lane + 8), b0 = *(const u32x4*)(Ob + 16 * lane), b1 = *(const u32x4*)(Ob + 16 * lane + 8);
    float v[16] = {bflo(a0.x) + bflo(b0.x), bfhi(a0.x) + bfhi(b0.x), bflo(a0.y) + bflo(b0.y), bfhi(a0.y) + bfhi(b0.y), bflo(a0.z) + bflo(b0.z), bfhi(a0.z) + bfhi(b0.z), bflo(a0.w) + bflo(b0.w), bfhi(a0.w) + bfhi(b0.w),
                   bflo(a1.x) + bflo(b1.x), bfhi(a1.x) + bfhi(b1.x), bflo(a1.y) + bflo(b1.y), bfhi(a1.y) + bfhi(b1.y), bflo(a1.z) + bflo(b1.z), bfhi(a1.z) + bfhi(b1.z), bflo(a1.w) + bflo(b1.w), bfhi(a1.w) + bfhi(b1.w)};
    float ss = 0.f;
#pragma unroll
    for (int i = 0; i < 16; ++i) ss += v[i] * v[i];
    ss += __shfl_xor(ss, 1); ss += __shfl_xor(ss, 2); ss += __shfl_xor(ss, 4);
    const float rs = rsqrtf(ss * (1.f / 128.f) + 1e-6f);
    const float* gp = gn + 16 * (lane & 7);
    u32x4 o0, o1;
    o0.x = pk2(v[0] * rs * gp[0], v[1] * rs * gp[1]); o0.y = pk2(v[2] * rs * gp[2], v[3] * rs * gp[3]); o0.z = pk2(v[4] * rs * gp[4], v[5] * rs * gp[5]); o0.w = pk2(v[6] * rs * gp[6], v[7] * rs * gp[7]);
    o1.x = pk2(v[8] * rs * gp[8], v[9] * rs * gp[9]); o1.y = pk2(v[10] * rs * gp[10], v[11] * rs * gp[11]); o1.z = pk2(v[12] * rs * gp[12], v[13] * rs * gp[13]); o1.w = pk2(v[14] * rs * gp[14], v[15] * rs * gp[15]);
    *(u32x4*)(Of + 16 * lane) = o0; *(u32x4*)(Of + 16 * lane + 8) = o1;
}
__device__ __forceinline__ float wave_sum(float v) {
#pragma unroll
    for (int o = 1; o < 64; o <<= 1) v += __shfl_xor(v, o);
    return v;
}
__device__ __forceinline__ void ln_row(float* row, const float* g, const float* bta, int lane) {
    f32x4* p = (f32x4*)row + lane;
    f32x4 v[4]; float s = 0.f;
#pragma unroll
    for (int j = 0; j < 4; ++j) { v[j] = p[64 * j]; s += (v[j].x + v[j].y) + (v[j].z + v[j].w); }
    const float mean = wave_sum(s) * (1.f / DM); float q = 0.f;
#pragma unroll
    for (int j = 0; j < 4; ++j) { v[j] = v[j] - mean; q += (v[j].x * v[j].x + v[j].y * v[j].y) + (v[j].z * v[j].z + v[j].w * v[j].w); }
    const float rstd = rsqrtf(wave_sum(q) * (1.f / DM) + 1e-5f);
#pragma unroll
    for (int j = 0; j < 4; ++j) { const f32x4 gg = ((const f32x4*)g)[lane + 64 * j], bb = ((const f32x4*)bta)[lane + 64 * j]; p[64 * j] = v[j] * rstd * gg + bb; }
}

#define XB_TMO      128
#define XB_XCNT(j)  (256  + 64 * (j))
#define XB_XSUB(j)  (1280 + 64 * (j))
#define XB_XGEN(j)  (2304 + 64 * (j))
#define XB_TOP      3328
#define XB_TOPGEN   3392
#define XCD_BAR_WORDS 3456
#define XB_SPIN_CAP (1u << 18)

__device__ __forceinline__ unsigned xb_ld(unsigned* p)              { return __hip_atomic_load(p, __ATOMIC_RELAXED, __HIP_MEMORY_SCOPE_AGENT); }
__device__ __forceinline__ unsigned xb_add(unsigned* p, unsigned v) { return __hip_atomic_fetch_add(p, v, __ATOMIC_RELAXED, __HIP_MEMORY_SCOPE_AGENT); }
__device__ __forceinline__ unsigned xb_xcc_id() { return (unsigned)__builtin_amdgcn_s_getreg((3 << 11) | 20) & 0xFu; }
#define XB_SPIN(cond, bar) do { unsigned _sp = 0; while (cond) { __builtin_amdgcn_s_sleep(1); \
    if ((++_sp & 255u) == 0u) { if (xb_ld(&(bar)[XB_TMO])) break; if (_sp > XB_SPIN_CAP) { atomicAdd(&(bar)[XB_TMO], 1u); break; } } } } while (0)

struct XcdBarrier {
    unsigned* bar; unsigned x;
    volatile LAS unsigned* st;
};

__device__ __forceinline__ XcdBarrier xcd_barrier_post(unsigned* bar, volatile LAS unsigned* st) {
    XcdBarrier b; b.bar = bar; b.x = xb_xcc_id(); b.st = st;
    if (threadIdx.x == 0) (void)xb_add(&bar[XB_XCNT(b.x)], 1u);
    return b;
}
__device__ __forceinline__ void xcd_barrier_complete(unsigned* bar, unsigned x, unsigned& nloc, unsigned& nx) {
    const unsigned G = gridDim.x * gridDim.y * gridDim.z;
    unsigned sum, cnt, mine, sp = 0u;
    for (;;) {
        sum = 0u; cnt = 0u; mine = 0u;
#pragma unroll
        for (unsigned j = 0; j < 16; ++j) { const unsigned c = xb_ld(&bar[XB_XCNT(j)]); sum += c; cnt += (c > 0u) ? 1u : 0u; mine = (j == x) ? c : mine; }
        if (sum == G) break;
        __builtin_amdgcn_s_sleep(1);
        if ((++sp & 255u) == 0u) { if (xb_ld(&bar[XB_TMO])) break; if (sp > XB_SPIN_CAP) { atomicAdd(&bar[XB_TMO], 1u); break; } }
    }
    nloc = mine > 0u ? mine : 1u; nx = cnt > 0u ? cnt : 1u;
}

__device__ __forceinline__ void xcd_barrier(const XcdBarrier& b) {
    asm volatile("s_waitcnt vmcnt(0)" ::: "memory");
    __syncthreads();
    if (threadIdx.x == 0) {
        unsigned* bar = b.bar;
        __builtin_amdgcn_s_waitcnt(0);
        unsigned nloc = b.st[0], nx = b.st[1];
        if (nloc == 0u) { xcd_barrier_complete(bar, b.x, nloc, nx); b.st[0] = nloc; b.st[1] = nx; }
        const unsigned old = xb_add(&bar[XB_XSUB(b.x)], 1u);
        const unsigned gen = old / nloc;
        if (old + 1u == (gen + 1u) * nloc) {
            __builtin_amdgcn_fence(__ATOMIC_RELEASE, "agent");
            asm volatile("s_waitcnt vmcnt(0)" ::: "memory");
            const unsigned og = xb_add(&bar[XB_TOP], 1u);
            const unsigned tg = og / nx;
            if (og + 1u == (tg + 1u) * nx) xb_add(&bar[XB_TOPGEN], 1u);
            else XB_SPIN(xb_ld(&bar[XB_TOPGEN]) == tg, bar);
            __builtin_amdgcn_fence(__ATOMIC_ACQUIRE, "agent");
            xb_add(&bar[XB_XGEN(b.x)], 1u);
            asm volatile("s_waitcnt vmcnt(0)" ::: "memory");
        } else {
            XB_SPIN(xb_ld(&bar[XB_XGEN(b.x)]) == gen, bar);
            __builtin_amdgcn_fence(__ATOMIC_ACQUIRE, "agent");
            asm volatile("s_waitcnt vmcnt(0)" ::: "memory");
        }
    }
    __syncthreads();
}

namespace cg = cooperative_groups;
#ifndef MK_SINGLE
#define MK_SINGLE 1
#endif
constexpr int N_PHASES = 9;
#ifndef DBG_STOP
#define DBG_STOP 99
#endif
__global__ void dbg_hsum(const bf16_t* hf, const bf16_t* hb, float* tmp) { const size_t i = (size_t)blockIdx.x * 256 + threadIdx.x; tmp[i] = bf2f(hf[i]) + bf2f(hb[i]); }
__global__ void dbg_copy(const float* tmp, float* out) { const size_t i = (size_t)blockIdx.x * 256 + threadIdx.x; out[i] = tmp[i]; }
__global__ void dbg_dump(const bf16_t* a0, const bf16_t* a1, const bf16_t* a2, const bf16_t* a3, const bf16_t* a4, const bf16_t* a5, float* out) {
    const size_t i = (size_t)blockIdx.x * 256 + threadIdx.x; float s = 0.f;
    if (a0) s += bf2f(a0[i]); if (a1) s += bf2f(a1[i]); if (a2) s += bf2f(a2[i]); if (a3) s += bf2f(a3[i]); if (a4) s += bf2f(a4[i]); if (a5) s += bf2f(a5[i]);
    out[i] = s;
}
struct Args { const float* in[22]; float* out; unsigned char* ws; int ph_lo, ph_hi; int mixmask, pad; };
__global__ void __launch_bounds__(NTHR, 2) fwd_kernel(Args a) {
    extern __shared__ __attribute__((aligned(16))) unsigned char lds_raw[];
    LAS unsigned char* lds = (LAS unsigned char*)lds_raw;
    const int tid = threadIdx.x, lane = tid & 63, wave = __builtin_amdgcn_readfirstlane(tid >> 6);
    const int G = gridDim.x, bx = blockIdx.x;
    const int vcu = (G % 8 == 0) ? (bx % 8) * (G / 8) + bx / 8 : bx;
    const int gw = vcu * NWAVES + wave, NGW = G * NWAVES;
    unsigned char* ws = a.ws;
    const float *x = a.in[0], *cvec = a.in[1], *ctx = a.in[2], *c_ctx = a.in[3], *w_mod = a.in[4], *b_mod = a.in[5], *w_in = a.in[6], *b_in = a.in[7], *lbl = a.in[8], *norm_g = a.in[9],
                *conv_w = a.in[10], *conv_b = a.in[11], *w_r = a.in[12], *b_r = a.in[13], *w_i = a.in[14], *b_i = a.in[15], *lam = a.in[16], *p_a = a.in[17], *p_b = a.in[18], *w_out = a.in[19],
                *ln_g = a.in[20], *ln_b = a.in[21];
    float* out = a.out;
    bf16_t* Wt_in = (bf16_t*)(ws + WS_WIN); bf16_t* Wt_pa = (bf16_t*)(ws + WS_WPA); bf16_t* Wt_pb = (bf16_t*)(ws + WS_WPB); bf16_t* Wt_out = (bf16_t*)(ws + WS_WOUT); bf16_t* Wg = (bf16_t*)(ws + WS_WG);
    float* modp = (float*)(ws + WS_MODP); float* gtv = (float*)(ws + WS_GT); float* Ddf = (float*)(ws + WS_DDF); float* Ddb = (float*)(ws + WS_DDB);
#define SLOTP(i) ((bf16_t*)(ws + WS_SLOTS + (size_t)(i) * SLOT))
    bf16_t *U = SLOTP(SL_U), *QDf = SLOTP(SL_QDF), *KIf = SLOTP(SL_KIF), *QDb = SLOTP(SL_QDB), *KIb = SLOTP(SL_KIB), *Vv = SLOTP(SL_V), *X5 = SLOTP(SL_X5);
    bf16_t* Hf = (bf16_t*)out; bf16_t* Hb = Hf + (size_t)LROWS * DM;
    bf16_t *A1 = KIf, *A2 = KIb, *S7 = Vv, *S8 = QDb, *YA = U, *Y = X5;
    cg::grid_group grid = cg::this_grid();
    volatile LAS unsigned* MISC = (volatile LAS unsigned*)(lds + MISC_OFF);
    if (tid < 32) MISC[tid] = 0u;
    __syncthreads();
    XcdBarrier xbar; xbar.bar = nullptr; xbar.x = 0; xbar.st = nullptr;
    if (a.ph_hi - a.ph_lo > 1) xbar = xcd_barrier_post((unsigned*)(ws + WS_CTL) + CW_BAR, MISC + 8);
    const int lo = a.ph_lo, hi = a.ph_hi;
#define IN(k) (lo <= (k) && (k) < hi)
#ifndef SEAM_CG_MASK
#define SEAM_CG_MASK 1
#endif
#define SEAM(k) do { if (IN(k) && IN((k) + 1)) { if ((SEAM_CG_MASK >> (k)) & 1) { __syncthreads(); grid.sync(); } else xcd_barrier(xbar); } } while (0)

    if (IN(0)) {
        LAS float* scr = (LAS float*)(lds + wave * 16384);
        constexpr int I_MP = 192, I_WIN = 16 * 288, I_SQ = 16 * 32, I_G = 256, NIT = I_MP + I_WIN + 3 * I_SQ + I_G;
        for (int it = gw; it < NIT; it += NGW) {
            int r = it;
            if (r < I_MP) { modp_item(cvec, c_ctx, w_mod, modp, r, lane); continue; } r -= I_MP;
            if (r < I_WIN) { transpose_item<1>(w_in, DM, 9216, Wt_in, scr, r, lane); continue; } r -= I_WIN;
            if (r < I_SQ) { transpose_item<2>(p_a, DM, DM, Wt_pa, scr, r, lane); continue; } r -= I_SQ;
            if (r < I_SQ) { transpose_item<2>(p_b, DM, DM, Wt_pb, scr, r, lane); continue; } r -= I_SQ;
            if (r < I_SQ) { transpose_item<0>(w_out, DM, DM, Wt_out, scr, r, lane); continue; } r -= I_SQ;
            { const int mi = r >> 4, ty = (r >> 3) & 1, sub = r & 7;
              transpose_item<0>((ty ? w_i : w_r) + (size_t)mi * 16384, 128, 128, Wg + (size_t)(mi * 2 + ty) * 16384, scr, sub, lane); }
        }
    }
    SEAM(0);
    if (IN(1)) {
        LAS float* tabL = (LAS float*)lds; LAS float* tabC = tabL + 2048;
        for (int wgi = vcu; wgi < 256; wgi += G) {
            const int b = wgi >> 6;
            __syncthreads();
#pragma unroll
            for (int v = 0; v < 4; ++v) { const int col = tid + 512 * v; float sl = b_mod[col], sc = sl;
#pragma unroll 4
                for (int kc = 0; kc < 16; ++kc) { sl += modp[(size_t)(kc * 5 + b) * 3072 + col]; sc += modp[(size_t)(kc * 5 + 4) * 3072 + col]; }
                if (col >= 1024) { sl += 1.f; sc += 1.f; }
                tabL[col] = sl; tabC[col] = sc; }
            if (wgi < 4) {
#pragma unroll
                for (int v = 0; v < 2; ++v) { const int col = tid + 512 * v; float s = b_mod[2048 + col];
                    for (int kc = 0; kc < 16; ++kc) s += modp[(size_t)(kc * 5 + wgi) * 3072 + 2048 + col];
                    gtv[wgi * DM + col] = s; }
            }
            __syncthreads();
            for (int i = 0; i < 16; ++i) { const int row = wgi * 128 + wave + 8 * i; urow(x + (size_t)row * DM, U + (size_t)row * DM, tabL, lane); }
            if (wave < 4) { const int r2 = wgi * 4 + wave; urow(ctx + (size_t)r2 * DM, U + (size_t)(LROWS + r2) * DM, tabC, lane); }
        }
    }
    SEAM(1);
    if (IN(2)) {
        pg8::Gemm g{U, Wt_in, ROWS, 5120, DM}; pg8::StaticOrder S; S.init(ROWS, 5120, G, bx);
        epi::EpiMix E{QDf, KIf, QDb, KIb, Vv, X5, Ddf, Ddb, b_in, lbl};
        pg8::gemm_phase<epi::EpiMix, pg8::StaticOrder, true, true>(lds, g, S, E);
    }
    SEAM(2);
    if (IN(3)) {
        if (bx < 64 && (a.mixmask & 1)) { const int b = bx >> 4, dir = (bx >> 3) & 1, h = bx & 7;
            mix::gla_wg(lds, b, h, dir, dir ? QDb : QDf, dir ? KIb : KIf, Vv, dir ? Ddb : Ddf);
        }
#ifdef RG_SEP
        __syncthreads(); grid.sync();
        if (bx >= 64 && bx < 128) {
#else
        else if (bx >= 64 && bx < 128 && (a.mixmask & 2)) {
#endif
            const int i = bx - 64, b = i >> 4, dir = (i >> 3) & 1, g = i & 7;
            mix::rglru_wg(lds, b, g, dir, X5, conv_w, conv_b, Wg, b_r, b_i, lam, dir ? Hb : Hf);
#ifdef RG_TWICE
            __syncthreads(); mix::rglru_wg(lds, b, g, dir, X5, conv_w, conv_b, Wg, b_r, b_i, lam, dir ? Hb : Hf);
#endif
        }
    }
    SEAM(3);
    if (IN(4)) {
        for (int row = gw; row < LROWS; row += NGW) norm_row(QDf + (size_t)row * DM, QDb + (size_t)row * DM, norm_g, lane);
    }
    SEAM(4);
    if (IN(5)) {
        pg8::Gemm g{U, Wt_in + (size_t)5120 * DM, LROWS, 4096, DM}; pg8::StaticOrder S; S.init(LROWS, 4096, G, bx);
        epi::EpiGate E{A1, A2, S7, S8, QDf, Hf, Hb, b_in};
        pg8::gemm_phase<epi::EpiGate, pg8::StaticOrder, true, true>(lds, g, S, E);
    }
    SEAM(5);
    if (IN(6)) {
        pg8::StaticOrder S; S.init(LROWS, DM, G, bx);
        { pg8::Gemm g{A1, Wt_pa, LROWS, DM, DM}; epi::EpiY<0> E{YA, S7, nullptr}; pg8::gemm_phase<epi::EpiY<0>, pg8::StaticOrder, true, true>(lds, g, S, E); }
        __syncthreads();
        { pg8::Gemm g{A2, Wt_pb, LROWS, DM, DM}; epi::EpiY<1> E{Y, S8, YA}; pg8::gemm_phase<epi::EpiY<1>, pg8::StaticOrder, true, true>(lds, g, S, E); }
    }
    SEAM(6);
    if (IN(7)) {
        pg8::Gemm g{Y, Wt_out, LROWS, DM, DM}; pg8::StaticOrder S; S.init(LROWS, DM, G, bx);
        epi::EpiPre E{x, out, gtv};
        pg8::gemm_phase<epi::EpiPre, pg8::StaticOrder, true, true>(lds, g, S, E);
    }
    SEAM(7);
    if (IN(8)) {
        for (int row = gw; row < LROWS; row += NGW) ln_row(out + (size_t)row * DM, ln_g, ln_b, lane);
    }
#undef IN
#undef SEAM
#undef SLOTP
}

extern "C" void kernel_launch(void* const* d_in, const int* in_sizes, int n_in, void* d_out, int out_size, void* d_ws, size_t ws_size, hipStream_t stream) {
    static int grid = 0;
    if (grid == 0) {
        int dev = 0, cus = 0, per_cu = 0;
        if (hipGetDevice(&dev) != hipSuccess || hipDeviceGetAttribute(&cus, hipDeviceAttributeMultiprocessorCount, dev) != hipSuccess) { fprintf(stderr, "kernel_launch: device query failed\n"); grid = -1; return; }
        if (hipFuncSetAttribute((const void*)fwd_kernel, hipFuncAttributeMaxDynamicSharedMemorySize, LDS_BYTES) != hipSuccess) { fprintf(stderr, "kernel_launch: hipFuncSetAttribute failed\n"); grid = -1; return; }
        if (hipOccupancyMaxActiveBlocksPerMultiprocessor(&per_cu, (const void*)fwd_kernel, NTHR, LDS_BYTES) != hipSuccess || per_cu < 1) { fprintf(stderr, "kernel_launch: occupancy query says %d\n", per_cu); per_cu = 1; }
        (void)hipGetLastError();
        grid = cus;
        if (ws_size < WS_END) { fprintf(stderr, "kernel_launch: workspace too small (%zu < %zu)\n", ws_size, (size_t)WS_END); grid = -1; return; }
    }
    if (grid < 0) return;
    if (hipMemsetAsync((char*)d_ws + WS_CTL, 0, CTL_ZERO_BYTES, stream) != hipSuccess) { fprintf(stderr, "kernel_launch: memset failed\n"); return; }
    Args a{};
    for (int i = 0; i < 22; ++i) a.in[i] = (const float*)d_in[i];
    a.out = (float*)d_out; a.ws = (unsigned char*)d_ws; a.mixmask = 3;
#if MK_SINGLE
    a.ph_lo = 0; a.ph_hi = N_PHASES;
    void* args[] = {&a};
    hipError_t e = hipLaunchCooperativeKernel((const void*)fwd_kernel, dim3(grid), dim3(NTHR), args, LDS_BYTES, stream);
    if (e != hipSuccess) fprintf(stderr, "cooperative launch failed: %s (grid %d)\n", hipGetErrorString(e), grid);
#else
#ifndef PHASE_LIST
#define PHASE_LIST 0, 1, 2, 3, 4, 5, 6, 7, 8
#endif
    { const int plist[] = {PHASE_LIST};
      for (int p0 : plist) { int p = p0; a.mixmask = 3; if (p0 >= 100) { p = 3; a.mixmask = p0 - 100; } if (p > (DBG_STOP == 30 ? 3 : DBG_STOP)) break; a.ph_lo = p; a.ph_hi = p + 1; hipLaunchKernelGGL(fwd_kernel, dim3(grid), dim3(NTHR), LDS_BYTES, stream, a); } }
#if DBG_STOP < 99
    { unsigned char* w = (unsigned char*)d_ws; auto SL = [&](int i) { return (const bf16_t*)(w + WS_SLOTS + (size_t)i * SLOT); };
      const bf16_t *p0 = nullptr, *p1 = nullptr, *p2 = nullptr, *p3 = nullptr, *p4 = nullptr, *p5 = nullptr;
      if (DBG_STOP == 1) { p0 = SL(SL_U); }
      if (DBG_STOP == 2) { p0 = SL(SL_QDF); p1 = SL(SL_KIF); p2 = SL(SL_QDB); p3 = SL(SL_KIB); p4 = SL(SL_V); p5 = SL(SL_X5); }
      if (DBG_STOP == 3) { p0 = SL(SL_QDF); p1 = SL(SL_QDB); }
      if (DBG_STOP == 4) { p0 = SL(SL_QDF); }
      if (DBG_STOP == 5) { p0 = SL(SL_KIF); p1 = SL(SL_KIB); p2 = SL(SL_V); p3 = SL(SL_QDB); }
      if (DBG_STOP == 6) { p0 = SL(SL_X5); }
      if (DBG_STOP == 30) { float* tmp = (float*)(w + WS_SLOTS); hipLaunchKernelGGL(dbg_hsum, dim3(LROWS * DM / 256), dim3(256), 0, stream, (const bf16_t*)d_out, (const bf16_t*)d_out + (size_t)LROWS * DM, tmp); hipLaunchKernelGGL(dbg_copy, dim3(LROWS * DM / 256), dim3(256), 0, stream, tmp, (float*)d_out); }
      else hipLaunchKernelGGL(dbg_dump, dim3(LROWS * DM / 256), dim3(256), 0, stream, p0, p1, p2, p3, p4, p5, (float*)d_out); }
#endif
#endif
}
```
